# Optimizing an MI355X kernel written in HIP

```python
import jax, jax.numpy as jnp
from jax import lax
import numpy as np

D_MODEL = 1024
BATCH = 8
SEQ = 2048
DEPTH = 1

PLE_DIM = 256
EPS = 1e-6
A_HEADS = 4
A_DQK = 128
A_DV = 256
A_QK_WIDTH = A_HEADS * A_DQK
A_WIDTH = A_HEADS * A_DV
A_CHUNK = 64
CONV_K = 4
B_HEADS = 16
B_DH = 64
B_WIDTH = B_HEADS * B_DH
Q_BLOCK = 128

IN_SPLITS = (A_QK_WIDTH, A_QK_WIDTH, A_WIDTH, A_HEADS, A_HEADS, A_WIDTH, A_WIDTH,
             B_WIDTH, B_WIDTH, B_WIDTH, B_HEADS, B_WIDTH, D_MODEL, D_MODEL)
N_IN = sum(IN_SPLITS)

kernel_name = "hybrid_mlstm_fox_gated_parallel"


def rms_norm(x, g):
    xf = x.astype(jnp.float32)
    y = xf * lax.rsqrt(jnp.mean(xf * xf, axis=-1, keepdims=True) + EPS)
    return (y * g.astype(jnp.float32)).astype(x.dtype)


def split_proj(proj):
    idx = np.cumsum(np.array(IN_SPLITS))[:-1].tolist()
    return jnp.split(proj, idx, axis=-1)


def heads(t, n_heads):
    b, s, c = t.shape
    return t.reshape(b, s, n_heads, c // n_heads).transpose(0, 2, 1, 3)


def merge_heads(t):
    b, h, s, d = t.shape
    return t.transpose(0, 2, 1, 3).reshape(b, s, h * d)


def causal_conv(x, w, b):
    s = x.shape[1]
    xp = jnp.pad(x, ((0, 0), (CONV_K - 1, 0), (0, 0)))
    y = xp[:, 0:s, :] * w[0]
    for kk in range(1, CONV_K):
        y = y + xp[:, kk:kk + s, :] * w[kk]
    return y + b


def mlstm_chunkwise(q, k, v, log_i, log_f):
    bsz, nh, s, dk = q.shape
    dv = v.shape[-1]
    nc = s // A_CHUNK

    def to_chunks(t):
        t = t.reshape((bsz, nh, nc, A_CHUNK) + t.shape[3:])
        return jnp.moveaxis(t, 2, 0)

    xs = (to_chunks(q), to_chunks(k), to_chunks(v), to_chunks(log_i), to_chunks(log_f))
    causal = jnp.tril(jnp.ones((A_CHUNK, A_CHUNK), dtype=bool))

    def step(carry, chunk):
        c_st, n_st, m_st = carry
        qj, kj, vj, ij, fj = chunk
        b = jnp.cumsum(fj, axis=-1)
        g = b[..., -1]
        dmat = b[..., :, None] - b[..., None, :] + ij[..., None, :]
        dmat = jnp.where(causal, dmat, -jnp.inf)
        inter = b + m_st[..., None]
        m_row = jnp.maximum(inter, jnp.max(dmat, axis=-1))
        w_intra = jnp.exp(dmat - m_row[..., None])
        w_inter = jnp.exp(inter - m_row)
        scores = jnp.einsum("bhld,bhsd->bhls", qj, kj) * w_intra
        num = (jnp.einsum("bhls,bhsv->bhlv", scores, vj)
               + w_inter[..., None] * jnp.einsum("bhld,bhdv->bhlv", qj, c_st))
        den = jnp.sum(scores, axis=-1) + w_inter * jnp.einsum("bhld,bhd->bhl", qj, n_st)
        h = num / jnp.maximum(jnp.abs(den), jnp.exp(-m_row))[..., None]
        to_end = g[..., None] - b + ij
        m_new = jnp.maximum(g + m_st, jnp.max(to_end, axis=-1))
        w_k = jnp.exp(to_end - m_new[..., None])
        decay = jnp.exp(g + m_st - m_new)
        c_new = decay[..., None, None] * c_st + jnp.einsum("bhs,bhsd,bhsv->bhdv", w_k, kj, vj)
        n_new = decay[..., None] * n_st + jnp.einsum("bhs,bhsd->bhd", w_k, kj)
        return (c_new, n_new, m_new), h

    init = (jnp.zeros((bsz, nh, dk, dv), jnp.float32),
            jnp.zeros((bsz, nh, dk), jnp.float32),
            jnp.zeros((bsz, nh), jnp.float32))
    _, hs = lax.scan(step, init, xs)
    return jnp.moveaxis(hs, 0, 2).reshape(bsz, nh, s, dv)


def forgetting_attention(q, k, v, log_f):
    s = q.shape[2]
    cum = jnp.cumsum(log_f, axis=-1)
    scale = B_DH ** -0.5
    outs = []
    for blk in range(s // Q_BLOCK):
        q0, q1 = blk * Q_BLOCK, (blk + 1) * Q_BLOCK
        qb = q[:, :, q0:q1]
        kb = k[:, :, :q1]
        vb = v[:, :, :q1]
        logits = (jnp.einsum("bhqd,bhkd->bhqk", qb, kb) * scale
                  + cum[:, :, q0:q1, None] - cum[:, :, None, :q1])
        mask = (q0 + jnp.arange(Q_BLOCK))[:, None] >= jnp.arange(q1)[None, :]
        logits = jnp.where(mask, logits, -jnp.inf)
        probs = jax.nn.softmax(logits, axis=-1)
        outs.append(jnp.einsum("bhqk,bhkd->bhqd", probs, vb))
    return jnp.concatenate(outs, axis=2)


def setup_inputs(seed: int = 0) -> dict:
    key = jax.random.key(seed)
    ks = jax.random.split(key, 17)
    f32 = jnp.float32

    def nrm(k, shape, scale):
        return jax.random.normal(k, shape, f32) * scale

    return {
        "x": nrm(ks[0], (BATCH, SEQ, D_MODEL), 1.0),
        "p": nrm(ks[1], (DEPTH, BATCH, SEQ, PLE_DIM), 1.0),
        "attn_norm_g": 1.0 + nrm(ks[2], (DEPTH, D_MODEL), 0.02),
        "w_in": nrm(ks[3], (DEPTH, D_MODEL, N_IN), D_MODEL ** -0.5),
        "conv_w": nrm(ks[4], (DEPTH, CONV_K, 2 * A_QK_WIDTH), 0.5),
        "conv_b": nrm(ks[5], (DEPTH, 2 * A_QK_WIDTH), 0.02),
        "a_bias_i": nrm(ks[6], (DEPTH, A_HEADS), 0.1),
        "a_bias_f": jnp.linspace(3.0, 6.0, A_HEADS, dtype=f32)[None, :] + nrm(ks[7], (DEPTH, A_HEADS), 0.1),
        "a_head_norm_g": 1.0 + nrm(ks[8], (DEPTH, A_WIDTH), 0.02),
        "b_bias_f": jnp.linspace(1.0, 4.0, B_HEADS, dtype=f32)[None, :] + nrm(ks[9], (DEPTH, B_HEADS), 0.1),
        "w_branch_a": nrm(ks[10], (DEPTH, A_WIDTH, D_MODEL), A_WIDTH ** -0.5),
        "w_branch_b": nrm(ks[11], (DEPTH, B_WIDTH, D_MODEL), B_WIDTH ** -0.5),
        "w_out": nrm(ks[12], (DEPTH, D_MODEL, D_MODEL), D_MODEL ** -0.5),
        "ple_norm_g": 1.0 + nrm(ks[13], (DEPTH, D_MODEL), 0.02),
        "w_ple_gate": nrm(ks[14], (DEPTH, D_MODEL, D_MODEL), D_MODEL ** -0.5),
        "w_ple_proj": nrm(ks[15], (DEPTH, PLE_DIM, D_MODEL), PLE_DIM ** -0.5),
        "final_norm_g": 1.0 + nrm(ks[16], (D_MODEL,), 0.02),
    }


def reference(x, p, attn_norm_g, w_in, conv_w, conv_b, a_bias_i, a_bias_f, a_head_norm_g,
              b_bias_f, w_branch_a, w_branch_b, w_out, ple_norm_g, w_ple_gate, w_ple_proj,
              final_norm_g):
    f32 = jnp.float32
    bsz, s, _ = x.shape
    for i in range(DEPTH):
        h = rms_norm(x, attn_norm_g[i])
        proj = h @ w_in[i]
        (a_q, a_k, a_v, a_i, a_f, a_o, a_z,
         b_q, b_k, b_v, b_f, b_z, g_a, g_b) = split_proj(proj)

        qk = jax.nn.silu(causal_conv(jnp.concatenate([a_q, a_k], axis=-1), conv_w[i], conv_b[i]))
        a_q, a_k = jnp.split(qk, 2, axis=-1)
        q_a = heads(a_q, A_HEADS).astype(f32)
        k_a = heads(a_k, A_HEADS).astype(f32) * (A_DQK ** -0.5)
        v_a = heads(a_v, A_HEADS).astype(f32)
        log_i = (a_i.astype(f32) + a_bias_i[i].astype(f32)).transpose(0, 2, 1)
        log_fa = jax.nn.log_sigmoid(a_f.astype(f32) + a_bias_f[i].astype(f32)).transpose(0, 2, 1)
        ha = mlstm_chunkwise(q_a, k_a, v_a, log_i, log_fa)
        ha = ha * lax.rsqrt(jnp.mean(ha * ha, axis=-1, keepdims=True) + EPS)
        ha = merge_heads(ha) * a_head_norm_g[i].astype(f32)
        ha = (jax.nn.sigmoid(a_o.astype(f32)) * ha).astype(x.dtype) * jax.nn.silu(a_z)
        y_a = ha @ w_branch_a[i]

        q_b = heads(b_q, B_HEADS).astype(f32)
        k_b = heads(b_k, B_HEADS).astype(f32)
        v_b = heads(b_v, B_HEADS).astype(f32)
        log_fb = jax.nn.log_sigmoid(b_f.astype(f32) + b_bias_f[i].astype(f32)).transpose(0, 2, 1)
        hb = forgetting_attention(q_b, k_b, v_b, log_fb)
        hb = merge_heads(hb).astype(x.dtype) * jax.nn.silu(b_z)
        y_b = hb @ w_branch_b[i]

        merged = jax.nn.sigmoid(g_a) * y_a + jax.nn.sigmoid(g_b) * y_b
        x = x + merged @ w_out[i]

        gate = jax.nn.sigmoid(rms_norm(x, ple_norm_g[i]) @ w_ple_gate[i])
        x = x + gate * (p[i] @ w_ple_proj[i])
    return rms_norm(x, final_norm_g)
```

```cpp
#include <hip/hip_runtime.h>
#include <cstdio>
#include <cstdint>
#include <cmath>
__device__ __forceinline__ int lane_now() { int l; asm volatile("s_nop 1\n\tv_mbcnt_lo_u32_b32 %0, -1, 0\n\tv_mbcnt_hi_u32_b32 %0, -1, %0" : "=v"(l)); return l; }
namespace pg8 {
#define PG8_LAS __attribute__((address_space(3)))
typedef unsigned short bf16_t;
typedef short bf16x8 __attribute__((ext_vector_type(8)));
typedef float f32x4 __attribute__((ext_vector_type(4)));
typedef unsigned u32x4 __attribute__((ext_vector_type(4)));
constexpr int BM = 256, BK = 64, HALF = 128, HTB = HALF * BK * 2  , STAGE_BYTES = 8 * HTB, NXCD = 8, WGM = 8;

__host__ __device__ __forceinline__ int lds_byte(int r, int c) { const int st = (r >> 4) * 2 + (c >> 5), rr = r & 15, cc = c & 31, ob = rr * 64 + cc * 2; return st * 1024 + (ob ^ (((ob >> 9) & 1) << 5)); }
__host__ __device__ __forceinline__ void stage_rc(int b, int& R, int& C) { const int st = b / 1024, sb = b % 1024, swz = sb ^ (((sb >> 9) & 1) << 5); R = (st >> 1) * 16 + swz / 64; C = (st & 1) * 32 + (swz % 64) / 2; }
__host__ __device__ __forceinline__ int perm32(int rho) { const int n = rho >> 4, i = rho & 15; return 8 * (i >> 2) + 4 * n + (i & 3); }

struct Unit { int pm, pn; };
struct Gemm { const bf16_t* A; const bf16_t* Bt; int M, N, K; };

struct StaticOrder {
    int nM, nN, nwg, G, c;
    __host__ __device__ void init(int M, int N, int G_, int c_) { nM = M / BM; nN = N / BM; nwg = nM * nN; G = G_; c = c_; }
    __host__ __device__ bool next(int i, Unit& u) const {
        const long L = (long)i * G + c; if (L >= nwg) return false;
        int wgid = (int)L; { const int q = nwg / NXCD, r = nwg % NXCD, xcd = wgid % NXCD, off = wgid / NXCD; wgid = (xcd < r ? xcd * (q + 1) : r * (q + 1) + (xcd - r) * q) + off; }
        const int nig = WGM * nN, gid = wgid / nig, fm = gid * WGM, gsz = (nM - fm) < WGM ? (nM - fm) : WGM;
        u.pm = fm + ((wgid % nig) % gsz); u.pn = (wgid % nig) / gsz; return true;
    }
    __device__ __forceinline__ void a_ready(const Unit&) const {}
    __device__ __forceinline__ void done(const Unit&) const {}
};

typedef unsigned u32x2 __attribute__((ext_vector_type(2)));
typedef float f32x2_t __attribute__((ext_vector_type(2))); typedef __bf16 bf16x2_t __attribute__((ext_vector_type(2)));
__device__ __forceinline__ unsigned cvt_pk_bf16(float lo, float hi) { f32x2_t v = {lo, hi}; bf16x2_t b = __builtin_convertvector(v, bf16x2_t); return __builtin_bit_cast(unsigned, b); }
__device__ __forceinline__ float bf_lo(unsigned w) { return __uint_as_float(w << 16); }
__device__ __forceinline__ float bf_hi(unsigned w) { return __uint_as_float(w & 0xffff0000u); }
__device__ __forceinline__ float sigmoidf_(float x) { return __builtin_amdgcn_rcpf(1.f + __expf(-x)); }
__device__ __forceinline__ float siluf_(float x) { return x * sigmoidf_(x); }
__device__ __forceinline__ u32x4 pack8(const f32x4 a, const f32x4 b) { u32x4 w; w.x = cvt_pk_bf16(a[0], a[1]); w.y = cvt_pk_bf16(a[2], a[3]); w.z = cvt_pk_bf16(b[0], b[1]); w.w = cvt_pk_bf16(b[2], b[3]); return w; }
__device__ __forceinline__ void unpack8(const u32x4 w, f32x4& a, f32x4& b) { a = (f32x4){bf_lo(w.x), bf_hi(w.x), bf_lo(w.y), bf_hi(w.y)}; b = (f32x4){bf_lo(w.z), bf_hi(w.z), bf_lo(w.w), bf_hi(w.w)}; }

constexpr float QSCALE = 0.125f * 1.4426950408889634f;

struct EpiP1 {
    static constexpr bool PERM = true, AFTER_DRAIN = false;
    bf16_t* s2;
    bf16_t* sbz;
    __device__ __forceinline__ void operator()(const f32x4 (&acc)[2][2][4][2], const Unit& u, int wr, int wc, int fr, int fq) const {
        const int grp = u.pn >> 2;
        const int row0 = u.pm * BM + wr * 64 + fr;
        constexpr size_t SLOT = (size_t)16384 * 1024;
        if (grp == 2 || grp == 3) {
            bf16_t* base = s2 + 2 * SLOT; const int col0 = 128 * (u.pn - 8) + wc * 32 + 8 * fq;
#pragma unroll
            for (int ai = 0; ai < 2; ++ai)
#pragma unroll
                for (int m = 0; m < 4; ++m) { bf16_t* rowp = base + (size_t)(row0 + ai * HALF + m * 16) * 1024 + col0;
                    f32x4 r0, r1;
#pragma unroll
                    for (int e = 0; e < 4; ++e) { r0[e] = sigmoidf_(acc[ai][0][m][0][e]) * siluf_(acc[ai][1][m][0][e]); r1[e] = sigmoidf_(acc[ai][0][m][1][e]) * siluf_(acc[ai][1][m][1][e]); }
                    *(u32x4*)rowp = pack8(r0, r1); }
        } else {
            const int sidx = grp < 2 ? grp : grp - 1;
            bf16_t* base = (grp == 7) ? sbz : s2 + (size_t)sidx * SLOT;
            const int col0 = (u.pn & 3) * BM + wc * 32 + 8 * fq;
            const float sc = (grp == 4) ? QSCALE : 1.f;
#pragma unroll
            for (int ai = 0; ai < 2; ++ai)
#pragma unroll
                for (int m = 0; m < 4; ++m) { bf16_t* rowp = base + (size_t)(row0 + ai * HALF + m * 16) * 1024 + col0;
#pragma unroll
                    for (int bj = 0; bj < 2; ++bj) { f32x4 v0 = acc[ai][bj][m][0] * sc, v1 = acc[ai][bj][m][1] * sc;
                        if (grp == 7) {
#pragma unroll
                            for (int e = 0; e < 4; ++e) { v0[e] = siluf_(v0[e]); v1[e] = siluf_(v1[e]); } }
                        *(u32x4*)(rowp + bj * HALF) = pack8(v0, v1); } }
        }
    }
};

template <int ACT  > struct EpiBf16Split {
    static constexpr bool PERM = true, AFTER_DRAIN = false;
    bf16_t* O0; bf16_t* O1;
    __device__ __forceinline__ void operator()(const f32x4 (&acc)[2][2][4][2], const Unit& u, int wr, int wc, int fr, int fq) const {
        const int row0 = u.pm * BM + wr * 64 + fr; bf16_t* base = (u.pn < 4) ? O0 : O1;
        const int col0 = (u.pn & 3) * BM + wc * 32 + 8 * fq;
#pragma unroll
        for (int ai = 0; ai < 2; ++ai)
#pragma unroll
            for (int m = 0; m < 4; ++m) { bf16_t* rowp = base + (size_t)(row0 + ai * HALF + m * 16) * 1024 + col0;
#pragma unroll
                for (int bj = 0; bj < 2; ++bj) { f32x4 v0 = acc[ai][bj][m][0], v1 = acc[ai][bj][m][1];
                    if (ACT == 1) {
#pragma unroll
                        for (int e = 0; e < 4; ++e) { v0[e] = sigmoidf_(v0[e]); v1[e] = sigmoidf_(v1[e]); } }
                    *(u32x4*)(rowp + bj * HALF) = pack8(v0, v1); } }
    }
};

template <int SECOND> struct EpiGate {
    static constexpr bool PERM = true, AFTER_DRAIN = false;
    bf16_t* T; const bf16_t* G2;
    __device__ __forceinline__ void operator()(const f32x4 (&acc)[2][2][4][2], const Unit& u, int wr, int wc, int fr, int fq) const {
        const int row0 = u.pm * BM + wr * 64 + fr; const int col0 = u.pn * BM + wc * 32 + 8 * fq;
#pragma unroll
        for (int ai = 0; ai < 2; ++ai)
#pragma unroll
            for (int m = 0; m < 4; ++m) { const size_t off = (size_t)(row0 + ai * HALF + m * 16) * 1024 + col0;
#pragma unroll
                for (int bj = 0; bj < 2; ++bj) {
                    f32x4 t0, t1; unpack8(*(const u32x4*)(T + off + bj * HALF), t0, t1);
                    f32x4 r0, r1;
                    if (SECOND) { f32x4 g0, g1; unpack8(*(const u32x4*)(G2 + off + bj * HALF), g0, g1); r0 = g0 * acc[ai][bj][m][0] + t0; r1 = g1 * acc[ai][bj][m][1] + t1; }
                    else { r0 = t0 * acc[ai][bj][m][0]; r1 = t1 * acc[ai][bj][m][1]; }
                    *(u32x4*)(T + off + bj * HALF) = pack8(r0, r1); } }
    }
};

struct EpiRes {
    static constexpr bool PERM = false, AFTER_DRAIN = false;
    const float* x; float* X1; bf16_t* XB1; float* SSP;
    __device__ __forceinline__ void operator()(const f32x4 (&acc)[2][2][4][2], const Unit& u, int wr, int wc, int fr, int fq) const {
        const int row0 = u.pm * BM + wr * 64 + fr, col0 = u.pn * BM + wc * 32 + 4 * fq;
#pragma unroll
        for (int ai = 0; ai < 2; ++ai)
#pragma unroll
            for (int m = 0; m < 4; ++m) { const int row = row0 + ai * HALF + m * 16; const size_t off = (size_t)row * 1024 + col0; float ss = 0.f;
#pragma unroll
                for (int bj = 0; bj < 2; ++bj)
#pragma unroll
                    for (int n = 0; n < 2; ++n) { const f32x4 xv = *(const f32x4*)(x + off + bj * HALF + n * 16); const f32x4 v = xv + acc[ai][bj][m][n];
                        *(f32x4*)(X1 + off + bj * HALF + n * 16) = v; ss += (v[0] * v[0] + v[1] * v[1]) + (v[2] * v[2] + v[3] * v[3]);
                        u32x2 w; w.x = cvt_pk_bf16(v[0], v[1]); w.y = cvt_pk_bf16(v[2], v[3]); *(u32x2*)(XB1 + off + bj * HALF + n * 16) = w; }
                ss += __shfl_xor(ss, 16); ss += __shfl_xor(ss, 32);
                if (fq == 0) SSP[(size_t)row * 16 + u.pn * 4 + wc] = ss; }
    }
};

struct EpiPle {
    static constexpr bool PERM = false, AFTER_DRAIN = false;
    float* X; const bf16_t* PP; const float* SSP1; float* SSP2; float eps;
    __device__ __forceinline__ void operator()(const f32x4 (&acc)[2][2][4][2], const Unit& u, int wr, int wc, int fr, int fq) const {
        const int row0 = u.pm * BM + wr * 64 + fr, col0 = u.pn * BM + wc * 32 + 4 * fq;
#pragma unroll
        for (int ai = 0; ai < 2; ++ai)
#pragma unroll
            for (int m = 0; m < 4; ++m) { const int row = row0 + ai * HALF + m * 16; const size_t off = (size_t)row * 1024 + col0;
                const f32x4* sp = (const f32x4*)(SSP1 + (size_t)row * 16); const f32x4 s0 = sp[0], s1 = sp[1], s2 = sp[2], s3 = sp[3];
                const float tot = ((s0[0] + s0[1]) + (s0[2] + s0[3])) + ((s1[0] + s1[1]) + (s1[2] + s1[3])) + ((s2[0] + s2[1]) + (s2[2] + s2[3])) + ((s3[0] + s3[1]) + (s3[2] + s3[3]));
                const float rstd = 1.0f / sqrtf(tot * (1.0f / 1024.0f) + eps); float ss = 0.f;
#pragma unroll
                for (int bj = 0; bj < 2; ++bj)
#pragma unroll
                    for (int n = 0; n < 2; ++n) { const f32x4 xv = *(const f32x4*)(X + off + bj * HALF + n * 16); const u32x2 pw = *(const u32x2*)(PP + off + bj * HALF + n * 16);
                        const f32x4 pp = (f32x4){bf_lo(pw.x), bf_hi(pw.x), bf_lo(pw.y), bf_hi(pw.y)}; f32x4 v;
#pragma unroll
                        for (int e = 0; e < 4; ++e) v[e] = xv[e] + sigmoidf_(rstd * acc[ai][bj][m][n][e]) * pp[e];
                        *(f32x4*)(X + off + bj * HALF + n * 16) = v; ss += (v[0] * v[0] + v[1] * v[1]) + (v[2] * v[2] + v[3] * v[3]); }
                ss += __shfl_xor(ss, 16); ss += __shfl_xor(ss, 32);
                if (fq == 0) SSP2[(size_t)row * 16 + u.pn * 4 + wc] = ss; }
    }
};

template <class Epi, class Sched, bool ALIGN_EPI = false, bool SP2 = false>
__device__ __forceinline__ void gemm_phase(PG8_LAS unsigned char* lds, const Gemm g, const Sched& S, const Epi& E, const int wave_id) {
    const int wid = wave_id, lane = lane_now(), tid = wid * 64 + lane, wr = wid >> 2, wc = wid & 3, fr = lane & 15, fq = lane >> 4;
    const int K = g.K, nt = K / BK;
    unsigned voffA[2], voffB[2];
#pragma unroll
    for (int i = 0; i < 2; ++i) { int R, C; stage_rc(tid * 16 + i * 8192, R, C); const int Rb = Epi::PERM ? ((R & ~31) + perm32(R & 31)) : R;
        voffA[i] = (unsigned)(R * K + C) * 2u; voffB[i] = (unsigned)(Rb * K + C) * 2u; }
    const size_t kstep = (size_t)(BK * 2);
    const size_t hstep = (size_t)HALF * K * 2;
    const size_t tstep = 2 * hstep;
    const unsigned ldsw = (unsigned)wid * 1024u;
    const int aoff = lds_byte(wr * 64 + fr, fq * 8), boff = lds_byte(wc * 32 + fr, fq * 8);
#define PG8_SA(b, h) (((b) * 2 + (h)) * HTB)
#define PG8_SB(b, h) ((4 + (b) * 2 + (h)) * HTB)
#define PG8_STAGE(bufoff, gbase, voff) do { _Pragma("unroll") for (int _i = 0; _i < 2; ++_i) \
        __builtin_amdgcn_global_load_lds((const unsigned*)((const char*)(gbase) + (voff)[_i]), (PG8_LAS unsigned*)(lds + (bufoff) + ldsw + _i * 8192), 16, 0, 0); } while (0)
#define PG8_LDA(dst, b, h) do { _Pragma("unroll") for (int m = 0; m < 4; ++m) _Pragma("unroll") for (int k = 0; k < 2; ++k) dst[m][k] = *(const PG8_LAS bf16x8*)(lds + PG8_SA(b, h) + aoff + m * 2048 + k * 1024); } while (0)
#define PG8_LDB(dst, b, h) do { _Pragma("unroll") for (int n = 0; n < 2; ++n) _Pragma("unroll") for (int k = 0; k < 2; ++k) dst[n][k] = *(const PG8_LAS bf16x8*)(lds + PG8_SB(b, h) + boff + n * 2048 + k * 1024); } while (0)
#define PG8_MMA(ai, bj, At, Bt) do { __builtin_amdgcn_s_setprio(1); _Pragma("unroll") for (int m = 0; m < 4; ++m) _Pragma("unroll") for (int n = 0; n < 2; ++n) _Pragma("unroll") for (int k = 0; k < 2; ++k) \
        acc[ai][bj][m][n] = __builtin_amdgcn_mfma_f32_16x16x32_bf16(Bt[n][k], At[m][k], acc[ai][bj][m][n], 0, 0, 0); __builtin_amdgcn_s_setprio(0); } while (0)
#define PG8_WAIT_V(n) asm volatile("s_waitcnt vmcnt(" #n ")" ::: "memory")
#define PG8_WAIT_L(n) asm volatile("s_waitcnt lgkmcnt(" #n ")" ::: "memory")
#define PG8_BAR __builtin_amdgcn_s_barrier()
#define PG8_SCHED __builtin_amdgcn_sched_barrier(0)
    Unit cur, nxt; int ui = 0;
    if (!S.next(0, cur)) return;
    f32x4 acc[2][2][4][2];
#pragma unroll
    for (int a = 0; a < 2; ++a)
#pragma unroll
        for (int b = 0; b < 2; ++b)
#pragma unroll
            for (int m = 0; m < 4; ++m)
#pragma unroll
                for (int n = 0; n < 2; ++n) acc[a][b][m][n] = (f32x4){0.f, 0.f, 0.f, 0.f};
    bf16x8 At[4][2], B0[2][2], B1[2][2];
    const char* cA = (const char*)g.A + (size_t)cur.pm * tstep; const char* cB = (const char*)g.Bt + (size_t)cur.pn * tstep;
    S.a_ready(cur);
    if constexpr (SP2) {
        PG8_STAGE(PG8_SB(0, 0), cB, voffB); PG8_STAGE(PG8_SB(0, 1), cB + hstep, voffB); PG8_STAGE(PG8_SA(0, 0), cA, voffA); PG8_STAGE(PG8_SA(0, 1), cA + hstep, voffA);
        if (wr == 1) PG8_BAR;
        PG8_WAIT_V(2); PG8_BAR;
        PG8_STAGE(PG8_SB(1, 0), cB + kstep, voffB); PG8_STAGE(PG8_SA(1, 0), cA + kstep, voffA); PG8_STAGE(PG8_SB(1, 1), cB + hstep + kstep, voffB);
        PG8_WAIT_V(6); PG8_BAR;
    } else {
        PG8_STAGE(PG8_SB(0, 0), cB, voffB); PG8_STAGE(PG8_SA(0, 0), cA, voffA); PG8_STAGE(PG8_SB(0, 1), cB + hstep, voffB); PG8_STAGE(PG8_SA(0, 1), cA + hstep, voffA);
        if (wr == 1) PG8_BAR;
        PG8_WAIT_V(4); PG8_BAR;
        PG8_STAGE(PG8_SB(1, 0), cB + kstep, voffB); PG8_STAGE(PG8_SA(1, 0), cA + kstep, voffA); PG8_STAGE(PG8_SB(1, 1), cB + hstep + kstep, voffB);
        PG8_WAIT_V(6); PG8_BAR;
    }
    for (;;) {
        const bool has_next = S.next(ui + 1, nxt);
        const char* nA = has_next ? (const char*)g.A + (size_t)nxt.pm * tstep : cA; const char* nB = has_next ? (const char*)g.Bt + (size_t)nxt.pn * tstep : cB;
        for (int t = 0; t < nt; t += 2) {
            const bool last = (t == nt - 2);
            const char* a1 = cA + (size_t)(t + 1) * kstep;
            const char* a2 = last ? nA : cA + (size_t)(t + 2) * kstep; const char* b2 = last ? nB : cB + (size_t)(t + 2) * kstep;
            const char* a3 = a2 + kstep; const char* b3 = b2 + kstep;
            if (last && has_next) S.a_ready(nxt);
            if constexpr (SP2) {
            PG8_LDB(B0, 0, 0); PG8_LDB(B1, 0, 1); PG8_SCHED; PG8_LDA(At, 0, 0); PG8_STAGE(PG8_SA(1, 1), a1 + hstep, voffA);
            PG8_WAIT_V(8); PG8_WAIT_L(0); PG8_BAR; PG8_MMA(0, 0, At, B0); PG8_MMA(0, 1, At, B1); PG8_BAR; PG8_SCHED;
            PG8_LDA(At, 0, 1); PG8_STAGE(PG8_SB(0, 0), b2, voffB); PG8_STAGE(PG8_SB(0, 1), b2 + hstep, voffB); PG8_STAGE(PG8_SA(0, 0), a2, voffA);
            PG8_WAIT_V(8); PG8_WAIT_L(0); PG8_BAR; PG8_MMA(1, 0, At, B0); PG8_MMA(1, 1, At, B1); PG8_BAR; PG8_SCHED;
            PG8_LDB(B0, 1, 0); PG8_LDB(B1, 1, 1); PG8_SCHED; PG8_LDA(At, 1, 0); PG8_STAGE(PG8_SA(0, 1), a2 + hstep, voffA);
            PG8_WAIT_V(8); PG8_WAIT_L(0); PG8_BAR; PG8_MMA(0, 0, At, B0); PG8_MMA(0, 1, At, B1); PG8_BAR; PG8_SCHED;
            PG8_LDA(At, 1, 1); PG8_STAGE(PG8_SB(1, 0), b3, voffB); PG8_STAGE(PG8_SB(1, 1), b3 + hstep, voffB); PG8_STAGE(PG8_SA(1, 0), a3, voffA);
            PG8_WAIT_V(8); PG8_WAIT_L(0); PG8_BAR; PG8_MMA(1, 0, At, B0); PG8_MMA(1, 1, At, B1); PG8_BAR; PG8_SCHED;
            } else {
            PG8_LDB(B0, 0, 0); PG8_SCHED; PG8_LDA(At, 0, 0); PG8_STAGE(PG8_SA(1, 1), a1 + hstep, voffA);
            PG8_WAIT_L(8); PG8_BAR; PG8_WAIT_L(0); PG8_MMA(0, 0, At, B0); PG8_BAR; PG8_SCHED;
            PG8_LDB(B1, 0, 1); PG8_STAGE(PG8_SB(0, 0), b2, voffB);
            PG8_BAR; PG8_WAIT_L(0); PG8_MMA(0, 1, At, B1); PG8_BAR;
            PG8_LDA(At, 0, 1); PG8_STAGE(PG8_SA(0, 0), a2, voffA);
            PG8_BAR; PG8_WAIT_L(0); PG8_MMA(1, 0, At, B0); PG8_BAR; PG8_SCHED;
            PG8_STAGE(PG8_SB(0, 1), b2 + hstep, voffB);
            PG8_WAIT_V(6); PG8_BAR; PG8_MMA(1, 1, At, B1); PG8_BAR;
            PG8_LDB(B0, 1, 0); PG8_SCHED; PG8_LDA(At, 1, 0); PG8_STAGE(PG8_SA(0, 1), a2 + hstep, voffA);
            PG8_WAIT_L(8); PG8_BAR; PG8_WAIT_L(0); PG8_MMA(0, 0, At, B0); PG8_BAR; PG8_SCHED;
            PG8_LDB(B1, 1, 1); PG8_STAGE(PG8_SB(1, 0), b3, voffB);
            PG8_BAR; PG8_WAIT_L(0); PG8_MMA(0, 1, At, B1); PG8_BAR;
            PG8_LDA(At, 1, 1); PG8_STAGE(PG8_SA(1, 0), a3, voffA);
            PG8_BAR; PG8_WAIT_L(0); PG8_MMA(1, 0, At, B0); PG8_BAR; PG8_SCHED;
            PG8_STAGE(PG8_SB(1, 1), b3 + hstep, voffB);
            PG8_WAIT_V(6); PG8_BAR; PG8_MMA(1, 1, At, B1); PG8_BAR;
            }
        }
        if constexpr (ALIGN_EPI) { if (wr == 0) PG8_BAR; }
        if constexpr (!Epi::AFTER_DRAIN) { E(acc, cur, wr, wc, fr, fq); S.done(cur); }
        if (!has_next) break;
#pragma unroll
        for (int a = 0; a < 2; ++a)
#pragma unroll
            for (int b = 0; b < 2; ++b)
#pragma unroll
                for (int m = 0; m < 4; ++m)
#pragma unroll
                    for (int n = 0; n < 2; ++n) acc[a][b][m][n] = (f32x4){0.f, 0.f, 0.f, 0.f};
        cur = nxt; cA = nA; cB = nB; ++ui;
        if constexpr (ALIGN_EPI) { if (wr == 1) PG8_BAR; }
    }
    PG8_WAIT_V(0);
    if constexpr (!ALIGN_EPI) { if (wr == 0) PG8_BAR; }
    PG8_BAR;
    if constexpr (Epi::AFTER_DRAIN) { E.fused(acc, cur, wr, wc, fr, fq, lds, wid, lane); S.done(cur); }
#undef PG8_SA
#undef PG8_SB
#undef PG8_STAGE
#undef PG8_LDA
#undef PG8_LDB
#undef PG8_MMA
#undef PG8_WAIT_V
#undef PG8_WAIT_L
#undef PG8_BAR
#undef PG8_SCHED
}
}

#ifndef PG8_SP2
#define PG8_SP2 true
#endif
#ifndef PG8_ALIGN
#define PG8_ALIGN true
#endif
#define GAS __attribute__((address_space(1)))
#define LAS __attribute__((address_space(3)))
typedef float f32x4 __attribute__((ext_vector_type(4)));

#define XB_TMO      128
#define XB_XCNT(j)  (256  + 64 * (j))
#define XB_XSUB(j)  (1280 + 64 * (j))
#define XB_XGEN(j)  (2304 + 64 * (j))
#define XB_TOP      3328
#define XB_TOPGEN   3392
#define XCD_BAR_WORDS 3456
#define XB_SPIN_CAP (1u << 18)

__device__ __forceinline__ unsigned xb_ld(unsigned* p)              { return __hip_atomic_load(p, __ATOMIC_RELAXED, __HIP_MEMORY_SCOPE_AGENT); }
__device__ __forceinline__ unsigned xb_add(unsigned* p, unsigned v) { return __hip_atomic_fetch_add(p, v, __ATOMIC_RELAXED, __HIP_MEMORY_SCOPE_AGENT); }
__device__ __forceinline__ unsigned xb_xcc_id() { return (unsigned)__builtin_amdgcn_s_getreg((3 << 11) | 20) & 0xFu; }
#define XB_SPIN(cond, bar) do { unsigned _sp = 0; while (cond) { __builtin_amdgcn_s_sleep(1); \
    if ((++_sp & 255u) == 0u) { if (xb_ld(&(bar)[XB_TMO])) break; if (_sp > XB_SPIN_CAP) { atomicAdd(&(bar)[XB_TMO], 1u); break; } } } } while (0)

struct XcdBarrier { unsigned* bar; unsigned x; volatile LAS unsigned* st; };

__device__ __forceinline__ XcdBarrier xcd_barrier_post(unsigned* bar, volatile LAS unsigned* st, int wave_id) {
    XcdBarrier b; b.bar = bar; b.x = xb_xcc_id(); b.st = st;
    if (wave_id == 0 && lane_now() == 0) (void)xb_add(&bar[XB_XCNT(b.x)], 1u);
    return b;
}
__device__ __forceinline__ void xcd_barrier_complete(unsigned* bar, unsigned x, unsigned& nloc, unsigned& nx) {
    const unsigned G = gridDim.x * gridDim.y * gridDim.z;
    unsigned sum, cnt, mine, sp = 0u;
    for (;;) {
        sum = 0u; cnt = 0u; mine = 0u;
#pragma unroll
        for (unsigned j = 0; j < 16; ++j) { const unsigned c = xb_ld(&bar[XB_XCNT(j)]); sum += c; cnt += (c > 0u) ? 1u : 0u; mine = (j == x) ? c : mine; }
        if (sum == G) break;
        __builtin_amdgcn_s_sleep(1);
        if ((++sp & 255u) == 0u) { if (xb_ld(&bar[XB_TMO])) break; if (sp > XB_SPIN_CAP) { atomicAdd(&bar[XB_TMO], 1u); break; } }
    }
    nloc = mine > 0u ? mine : 1u; nx = cnt > 0u ? cnt : 1u;
}
__device__ __forceinline__ void xcd_barrier(const XcdBarrier& b, int wave_id) {
    asm volatile("s_waitcnt vmcnt(0)" ::: "memory");
    __syncthreads();
    if (wave_id == 0 && lane_now() == 0) {
        unsigned* bar = b.bar;
        __builtin_amdgcn_s_waitcnt(0);
        unsigned nloc = b.st[0], nx = b.st[1];
        if (nloc == 0u) { xcd_barrier_complete(bar, b.x, nloc, nx); b.st[0] = nloc; b.st[1] = nx; }
        const unsigned old = xb_add(&bar[XB_XSUB(b.x)], 1u);
        const unsigned gen = old / nloc;
        if (old + 1u == (gen + 1u) * nloc) {
            __builtin_amdgcn_fence(__ATOMIC_RELEASE, "agent");
            asm volatile("s_waitcnt vmcnt(0)" ::: "memory");
            const unsigned og = xb_add(&bar[XB_TOP], 1u);
            const unsigned tg = og / nx;
            if (og + 1u == (tg + 1u) * nx) xb_add(&bar[XB_TOPGEN], 1u);
            else XB_SPIN(xb_ld(&bar[XB_TOPGEN]) == tg, bar);
            __builtin_amdgcn_fence(__ATOMIC_ACQUIRE, "agent");
            xb_add(&bar[XB_XGEN(b.x)], 1u);
            asm volatile("s_waitcnt vmcnt(0)" ::: "memory");
        } else {
            XB_SPIN(xb_ld(&bar[XB_XGEN(b.x)]) == gen, bar);
            __builtin_amdgcn_fence(__ATOMIC_ACQUIRE, "agent");
            asm volatile("s_waitcnt vmcnt(0)" ::: "memory");
        }
    }
    __syncthreads();
}

constexpr int NWAVES = 8;
constexpr int BATCH = 8, SEQ = 2048, DM = 1024, M = BATCH * SEQ, PLE = 256, NIN = 10264;
constexpr int C_AQ = 0, C_AK = 512, C_AV = 1024, C_AI = 2048, C_AF = 2052, C_AO = 2056, C_AZ = 3080, C_BQ = 4104, C_BK = 5128, C_BV = 6152, C_BF = 7176, C_BZ = 7192, C_GA = 8216, C_GB = 9240;
constexpr float EPS = 1e-6f;
constexpr size_t MiB = 1u << 20;
constexpr size_t WS_CTL = 0, CTL_ZERO_BYTES = 1 * MiB;
constexpr size_t WS_BT1 = 1 * MiB, WS_BT3 = 17 * MiB, WS_WAT = 21 * MiB, WS_WBT = 23 * MiB, WS_WOT = 25 * MiB, WS_WGT = 27 * MiB, WS_WPT = 29 * MiB;
constexpr size_t WS_LI = 29 * MiB + 512 * 1024, WS_LFA = WS_LI + 256 * 1024, WS_LFB = 30 * MiB;
constexpr size_t WS_S1 = 32 * MiB, WS_S2 = 64 * MiB, WS_S3 = 96 * MiB, WS_S4 = 128 * MiB, WS_S5 = 160 * MiB, WS_S6 = 192 * MiB, WS_S7 = 224 * MiB, WS_END = 256 * MiB;
constexpr size_t DO_SBZ = 0, DO_PB = 32 * MiB, DO_CUMB = 40 * MiB;
constexpr int CW_BAR = 4096;
constexpr int LDS_BYTES = 147456, MISC_OFF = 131072 + 320;

typedef unsigned short bf16;
typedef unsigned v4u __attribute__((ext_vector_type(4)));
#define LDS_WAIT() asm volatile("s_waitcnt lgkmcnt(0)" ::: "memory")
__device__ __forceinline__ unsigned f2bf(float f) { unsigned u = __builtin_bit_cast(unsigned, f); return (u + 0x7fffu + ((u >> 16) & 1u)) >> 16; }
__device__ __forceinline__ unsigned pk2(float lo, float hi) { return f2bf(lo) | (f2bf(hi) << 16); }
__device__ __forceinline__ float bf2f(bf16 v) { return __uint_as_float((unsigned)v << 16); }
__device__ __forceinline__ float wave_sum(float v) {
#pragma unroll
    for (int o = 1; o < 64; o <<= 1) v += __shfl_xor(v, o);
    return v;
}

__device__ __forceinline__ int bt1_src_col(int n) {
    const int tile = n >> 8, r = n & 255;
    if (tile < 4) return C_AQ + 256 * tile + r;
    if (tile < 8) return C_AV + 256 * (tile - 4) + r;
    if (tile < 16) { const int t = tile - 8; return r < 128 ? C_AO + 128 * t + r : C_AZ + 128 * t + (r - 128); }
    if (tile < 20) return C_BQ + 256 * (tile - 16) + r;
    if (tile < 24) return C_BK + 256 * (tile - 20) + r;
    if (tile < 28) return C_BV + 256 * (tile - 24) + r;
    return C_BZ + 256 * (tile - 28) + r;
}
__device__ __forceinline__ int bt3_src_col(int n) { return n < 1024 ? C_GA + n : C_GB + (n - 1024); }

__device__ __forceinline__ void transpose_item(const float* W, int ld, int srccol0, int k0, bf16* WT, int K, int dstrow0, const float* kscale, LAS float* scr, int lane) {
#pragma unroll 8
    for (int i = 0; i < 32; ++i) { const int kk = 2 * i + (lane >> 5); float v = W[(size_t)(k0 + kk) * ld + srccol0 + (lane & 31)]; if (kscale) v *= kscale[k0 + kk]; scr[kk * 33 + (lane & 31)] = v; }
    LDS_WAIT(); asm volatile("" ::: "memory");
    const int c = lane & 7;
#pragma unroll
    for (int j = 0; j < 4; ++j) { const int n = (lane >> 3) + 8 * j; const LAS float* s = scr + (8 * c) * 33 + n;
        v4u o; o.x = pk2(s[0 * 33], s[1 * 33]); o.y = pk2(s[2 * 33], s[3 * 33]); o.z = pk2(s[4 * 33], s[5 * 33]); o.w = pk2(s[6 * 33], s[7 * 33]);
        *(GAS v4u*)(WT + (size_t)(dstrow0 + n) * K + k0 + 8 * c) = o; }
    LDS_WAIT(); asm volatile("" ::: "memory");
}

struct Args { const float* in[17]; float* out; unsigned char* ws; int ph_lo, ph_hi; };

__device__ __forceinline__ void p0_prologue(const Args& a, LAS unsigned char* lds, int gw, int NGW, int wave, int lane) {
    LAS float* scr = (LAS float*)(lds + wave * 16384);
    unsigned char* ws = a.ws;
    const float* w_in = a.in[3];
    constexpr int I1 = 256 * 16, I3 = 64 * 16, IW = 32 * 16, IP = 32 * 4;
    constexpr int NITEMS = I1 + I3 + 4 * IW + IP;
    for (int it = gw; it < NITEMS; it += NGW) {
        int r = it;
        if (r < I1) { const int nb = r >> 4, kb = r & 15; transpose_item(w_in, NIN, bt1_src_col(32 * nb), 64 * kb, (bf16*)(ws + WS_BT1), 1024, 32 * nb, nullptr, scr, lane); continue; } r -= I1;
        if (r < I3) { const int nb = r >> 4, kb = r & 15; transpose_item(w_in, NIN, bt3_src_col(32 * nb), 64 * kb, (bf16*)(ws + WS_BT3), 1024, 32 * nb, nullptr, scr, lane); continue; } r -= I3;
        if (r < IW) { const int nb = r >> 4, kb = r & 15; transpose_item(a.in[10], 1024, 32 * nb, 64 * kb, (bf16*)(ws + WS_WAT), 1024, 32 * nb, nullptr, scr, lane); continue; } r -= IW;
        if (r < IW) { const int nb = r >> 4, kb = r & 15; transpose_item(a.in[11], 1024, 32 * nb, 64 * kb, (bf16*)(ws + WS_WBT), 1024, 32 * nb, nullptr, scr, lane); continue; } r -= IW;
        if (r < IW) { const int nb = r >> 4, kb = r & 15; transpose_item(a.in[12], 1024, 32 * nb, 64 * kb, (bf16*)(ws + WS_WOT), 1024, 32 * nb, nullptr, scr, lane); continue; } r -= IW;
        if (r < IW) { const int nb = r >> 4, kb = r & 15; transpose_item(a.in[14], 1024, 32 * nb, 64 * kb, (bf16*)(ws + WS_WGT), 1024, 32 * nb, a.in[13], scr, lane); continue; } r -= IW;
        { const int nb = r >> 2, kb = r & 3; transpose_item(a.in[15], 1024, 32 * nb, 64 * kb, (bf16*)(ws + WS_WPT), 256, 32 * nb, nullptr, scr, lane); }
    }
    const float* x = a.in[0]; const float* g = a.in[2];
    f32x4 gv[4];
#pragma unroll
    for (int j = 0; j < 4; ++j) gv[j] = ((const f32x4*)g)[lane + 64 * j];
    for (int m = gw; m < M; m += NGW) {
        const GAS f32x4* xr = (const GAS f32x4*)(x + (size_t)m * DM) + lane; f32x4 v[4]; float s = 0.f;
#pragma unroll
        for (int j = 0; j < 4; ++j) { v[j] = xr[64 * j]; s += (v[j].x * v[j].x + v[j].y * v[j].y) + (v[j].z * v[j].z + v[j].w * v[j].w); }
        const float rstd = 1.f / sqrtf(wave_sum(s) * (1.f / DM) + EPS);
        GAS unsigned long long* o8 = (GAS unsigned long long*)(ws + WS_S1 + (size_t)m * DM * 2) + lane;
#pragma unroll
        for (int j = 0; j < 4; ++j) { const f32x4 y = v[j] * rstd * gv[j]; o8[64 * j] = (unsigned long long)pk2(y.x, y.y) | ((unsigned long long)pk2(y.z, y.w) << 32); }
    }
    const float* p = a.in[1];
    for (int m = gw; m < M; m += NGW) {
        const f32x4 v = ((const GAS f32x4*)(p + (size_t)m * PLE))[lane];
        ((GAS unsigned long long*)((unsigned char*)a.out + DO_PB + (size_t)m * PLE * 2))[lane] = (unsigned long long)pk2(v.x, v.y) | ((unsigned long long)pk2(v.z, v.w) << 32);
    }
}

__global__ void __launch_bounds__(NWAVES * 64, 2) fwd(Args args) {
    extern __shared__ __attribute__((aligned(16))) unsigned char lds_raw[];
    LAS unsigned char* lds = (LAS unsigned char*)lds_raw;
    const int wave = __builtin_amdgcn_readfirstlane(threadIdx.x >> 6);
    const int G = gridDim.x;
    volatile LAS unsigned* MISC = (volatile LAS unsigned*)(lds + MISC_OFF);
    for (int u = wave * 64 + lane_now(); u < (LDS_BYTES - 131072) / 4; u += NWAVES * 64) ((LAS unsigned*)(lds + 131072))[u] = 0u;
    __syncthreads();
    unsigned char* ws = args.ws;
    unsigned* ctl = (unsigned*)ws;
    const int lo = args.ph_lo, hi = args.ph_hi;
    XcdBarrier bar; bar.bar = ctl + CW_BAR; bar.x = 0; bar.st = nullptr;
    if (hi - lo > 1) bar = xcd_barrier_post(ctl + CW_BAR, MISC + 8, wave);
#define IN(k) (lo <= (k) && (k) < hi)
#define BOTH(k) (IN(k) && IN((k) + 1))
    using pg8::bf16_t;
    bf16_t* S1 = (bf16_t*)(ws + WS_S1); bf16_t* S2 = (bf16_t*)(ws + WS_S2); bf16_t* S3 = (bf16_t*)(ws + WS_S3); bf16_t* S4 = (bf16_t*)(ws + WS_S4);
    bf16_t* S5 = (bf16_t*)(ws + WS_S5); bf16_t* S6 = (bf16_t*)(ws + WS_S6);
    float* SSP1 = (float*)(ws + WS_S7); float* SSP2 = (float*)(ws + WS_S7 + MiB);

    if (IN(0)) { p0_prologue(args, lds, (int)blockIdx.x * NWAVES + wave, G * NWAVES, wave, lane_now()); if (BOTH(0)) xcd_barrier(bar, wave); }

    if (IN(1)) {
        pg8::Gemm g{S1, (const bf16_t*)(ws + WS_BT1), M, 8192, 1024}; pg8::StaticOrder S; S.init(M, 8192, G, (int)blockIdx.x);
        pg8::EpiP1 E{S2, (bf16_t*)((unsigned char*)args.out + DO_SBZ)};
        pg8::gemm_phase<pg8::EpiP1, pg8::StaticOrder, PG8_ALIGN, PG8_SP2>(lds, g, S, E, wave);
        if (BOTH(1)) xcd_barrier(bar, wave);
    }
    if (IN(3)) {
        { pg8::Gemm g{S1, (const bf16_t*)(ws + WS_BT3), M, 2048, 1024}; pg8::StaticOrder S; S.init(M, 2048, G, (int)blockIdx.x);
          pg8::EpiBf16Split<1> E{S2, S3};
          pg8::gemm_phase<pg8::EpiBf16Split<1>, pg8::StaticOrder, PG8_ALIGN, PG8_SP2>(lds, g, S, E, wave); }
        { int kpp = 256; asm volatile("" : "+s"(kpp));
          pg8::Gemm g{(const bf16_t*)((unsigned char*)args.out + DO_PB), (const bf16_t*)(ws + WS_WPT), M, 1024, kpp}; pg8::StaticOrder S; S.init(M, 1024, G, (int)blockIdx.x);
          pg8::EpiBf16Split<0> E{S6, S6};
          pg8::gemm_phase<pg8::EpiBf16Split<0>, pg8::StaticOrder, PG8_ALIGN, PG8_SP2>(lds, g, S, E, wave); }
        if (BOTH(3)) xcd_barrier(bar, wave);
    }
    if (IN(4)) {
        { pg8::Gemm g{S4, (const bf16_t*)(ws + WS_WAT), M, 1024, 1024}; pg8::StaticOrder S; S.init(M, 1024, G, (int)blockIdx.x);
          pg8::EpiGate<0> E{S2, nullptr};
          pg8::gemm_phase<pg8::EpiGate<0>, pg8::StaticOrder, false, PG8_SP2>(lds, g, S, E, wave); }
        { pg8::Gemm g{S5, (const bf16_t*)(ws + WS_WBT), M, 1024, 1024}; pg8::StaticOrder S; S.init(M, 1024, G, (int)blockIdx.x);
          pg8::EpiGate<1> E{S2, S3};
          pg8::gemm_phase<pg8::EpiGate<1>, pg8::StaticOrder, false, PG8_SP2>(lds, g, S, E, wave); }
        if (BOTH(4)) xcd_barrier(bar, wave);
    }
    if (IN(5)) {
        pg8::Gemm g{S2, (const bf16_t*)(ws + WS_WOT), M, 1024, 1024}; pg8::StaticOrder S; S.init(M, 1024, G, (int)blockIdx.x);
        pg8::EpiRes E{args.in[0], args.out, S1, SSP1};
        pg8::gemm_phase<pg8::EpiRes, pg8::StaticOrder, false, PG8_SP2>(lds, g, S, E, wave);
        if (BOTH(5)) xcd_barrier(bar, wave);
    }
    if (IN(6)) {
        pg8::Gemm g{S1, (const bf16_t*)(ws + WS_WGT), M, 1024, 1024}; pg8::StaticOrder S; S.init(M, 1024, G, (int)blockIdx.x);
        pg8::EpiPle E{args.out, S6, SSP1, SSP2, EPS};
        pg8::gemm_phase<pg8::EpiPle, pg8::StaticOrder, false, PG8_SP2>(lds, g, S, E, wave);
    }
#undef IN
#undef BOTH
}

__device__ __forceinline__ float log_sigmoid_f(float z) { return fminf(z, 0.f) - log1pf(expf(-fabsf(z))); }

__global__ void __launch_bounds__(256) small_gates_naive(const bf16* XN, const float* w_in, const float* bias_i, const float* bias_fa, const float* bias_fb, float* LI, float* LFA, float* LFB) {
    const int lane = threadIdx.x & 63, row = blockIdx.x * 4 + (threadIdx.x >> 6);
    float xv[16];
#pragma unroll
    for (int i = 0; i < 16; ++i) xv[i] = bf2f(XN[(size_t)row * DM + lane + 64 * i]);
    for (int c = 0; c < 24; ++c) {
        const int col = c < 4 ? C_AI + c : (c < 8 ? C_AF + (c - 4) : C_BF + (c - 8));
        float s = 0.f;
#pragma unroll
        for (int i = 0; i < 16; ++i) s += xv[i] * w_in[(size_t)(lane + 64 * i) * NIN + col];
        s = wave_sum(s);
        if (lane == 0) {
            if (c < 4) LI[(size_t)row * 4 + c] = s + bias_i[c];
            else if (c < 8) LFA[(size_t)row * 4 + (c - 4)] = log_sigmoid_f(s + bias_fa[c - 4]);
            else LFB[(size_t)row * 16 + (c - 8)] = log_sigmoid_f(s + bias_fb[c - 8]);
        }
    }
}

__global__ void __launch_bounds__(256) mlstm_naive(const bf16* AQK, const bf16* AV, bf16* GATEA_HA, const float* LI, const float* LFA, const float* conv_w, const float* conv_b, const float* hn_g) {
    const int b = blockIdx.x >> 2, h = blockIdx.x & 3, v = threadIdx.x;
    __shared__ float qs[128], ks[128], red[8], red2[8];
    float C[128];
#pragma unroll
    for (int d = 0; d < 128; ++d) C[d] = 0.f;
    float nreg = 0.f, mst = 0.f;
    const int ch = (v < 128) ? (h * 128 + v) : (512 + h * 128 + (v - 128));
    const float w0 = conv_w[0 * 1024 + ch], w1 = conv_w[1 * 1024 + ch], w2 = conv_w[2 * 1024 + ch], w3 = conv_w[3 * 1024 + ch], cb = conv_b[ch];
    float x0 = 0.f, x1 = 0.f, x2 = 0.f;
    const float hg = hn_g[h * 256 + v];
    for (int t = 0; t < SEQ; ++t) {
        const size_t row = (size_t)b * SEQ + t;
        const float x3 = bf2f(AQK[row * 1024 + ch]);
        float y = x0 * w0 + x1 * w1 + x2 * w2 + x3 * w3 + cb; x0 = x1; x1 = x2; x2 = x3;
        y = y / (1.f + expf(-y));
        if (v < 128) qs[v] = y; else ks[v - 128] = y * 0.08838834764831845f;
        __syncthreads();
        const float li = LI[row * 4 + h], lf = LFA[row * 4 + h];
        const float mnew = fmaxf(lf + mst, li), fs = expf(lf + mst - mnew), is = expf(li - mnew); mst = mnew;
        const float vt = bf2f(AV[row * 1024 + h * 256 + v]);
        float num = 0.f; const float iv = is * vt;
#pragma unroll
        for (int d = 0; d < 128; ++d) { C[d] = fs * C[d] + iv * ks[d]; num += qs[d] * C[d]; }
        float dp = 0.f;
        if (v < 128) { nreg = fs * nreg + is * ks[v]; dp = nreg * qs[v]; }
        dp = wave_sum(dp);
        if ((v & 63) == 0) red[v >> 6] = dp;
        __syncthreads();
        const float den = red[0] + red[1] + red[2] + red[3];
        const float hval = num / fmaxf(fabsf(den), expf(-mnew));
        float sq = wave_sum(hval * hval);
        if ((v & 63) == 0) red2[v >> 6] = sq;
        __syncthreads();
        const float ms = (red2[0] + red2[1] + red2[2] + red2[3]) * (1.f / 256.f);
        const size_t o = row * 1024 + h * 256 + v;
        const float outv = hval * (1.f / sqrtf(ms + EPS)) * hg * bf2f(GATEA_HA[o]);
        GATEA_HA[o] = (bf16)f2bf(outv);
    }
}

__global__ void cum_naive(const float* LFB, float* CUMB) {
    const int i = blockIdx.x * blockDim.x + threadIdx.x; if (i >= BATCH * 16) return;
    const int b = i >> 4, h = i & 15; float s = 0.f;
    for (int t = 0; t < SEQ; ++t) { s += LFB[((size_t)b * SEQ + t) * 16 + h]; CUMB[(size_t)i * SEQ + t] = s; }
}

__global__ void __launch_bounds__(256) attn_naive(bf16* BQ_HB, const bf16* BK, const bf16* BV, const bf16* SBZ, const float* CUMB) {
    const int bh = blockIdx.x >> 3, qb = blockIdx.x & 7, b = bh >> 4, h = bh & 15, tq = qb * 256 + threadIdx.x;
    __shared__ float Ks[64][65], Vs[64][65], cs[64];
    const size_t rowq = (size_t)b * SEQ + tq;
    float q[64], o[64];
#pragma unroll
    for (int d = 0; d < 64; ++d) { q[d] = bf2f(BQ_HB[rowq * 1024 + h * 64 + d]); o[d] = 0.f; }
    const float L2E = 1.4426950408889634f;
    const float cq = CUMB[(size_t)bh * SEQ + tq] * L2E;
    float mrun = -INFINITY, l = 0.f;
    const int ntile = (qb * 256 + 256) / 64;
    for (int kt = 0; kt < ntile; ++kt) {
        __syncthreads();
        for (int i = threadIdx.x; i < 64 * 64; i += 256) { const int r = i >> 6, d = i & 63; const size_t rk = ((size_t)b * SEQ + kt * 64 + r) * 1024 + h * 64 + d; Ks[r][d] = bf2f(BK[rk]); Vs[r][d] = bf2f(BV[rk]); }
        if (threadIdx.x < 64) cs[threadIdx.x] = CUMB[(size_t)bh * SEQ + kt * 64 + threadIdx.x] * L2E;
        __syncthreads();
        for (int r = 0; r < 64; ++r) {
            const int tk = kt * 64 + r; if (tk > tq) break;
            float s = 0.f;
#pragma unroll
            for (int d = 0; d < 64; ++d) s += q[d] * Ks[r][d];
            s += cq - cs[r];
            if (s > mrun) { const float f = exp2f(mrun - s); l *= f;
#pragma unroll
                for (int d = 0; d < 64; ++d) o[d] *= f;
                mrun = s; }
            const float pexp = exp2f(s - mrun); l += pexp;
#pragma unroll
            for (int d = 0; d < 64; ++d) o[d] += pexp * Vs[r][d];
        }
    }
    const float inv = 1.f / l;
#pragma unroll
    for (int d = 0; d < 64; ++d) { const size_t oo = rowq * 1024 + h * 64 + d; BQ_HB[oo] = (bf16)f2bf(o[d] * inv * bf2f(SBZ[oo])); }
}

__global__ void __launch_bounds__(256) final_naive(float* X, const float* SSP2, const float* g) {
    const int lane = threadIdx.x & 63, row = blockIdx.x * 4 + (threadIdx.x >> 6);
    float tot = 0.f;
    for (int i = 0; i < 16; ++i) tot += SSP2[(size_t)row * 16 + i];
    const float rstd = 1.f / sqrtf(tot * (1.f / DM) + EPS);
    f32x4* xr = (f32x4*)(X + (size_t)row * DM) + lane;
#pragma unroll
    for (int j = 0; j < 4; ++j) { const f32x4 gv = ((const f32x4*)g)[lane + 64 * j]; xr[64 * j] = xr[64 * j] * rstd * gv; }
}


#ifdef DBG
__device__ __forceinline__ unsigned hash_u(unsigned x) { x ^= x >> 16; x *= 0x7feb352du; x ^= x >> 15; x *= 0x846ca68bu; x ^= x >> 16; return x; }
__device__ __forceinline__ float rbf(float f) { return __uint_as_float(f2bf(f) << 16); }
__device__ __forceinline__ float dot_bf(const bf16* a, const float* W, int ld, int col, int K, const float* ks) {
    float s = 0.f; for (int k = 0; k < K; ++k) { float w = W[(size_t)k * ld + col]; if (ks) w *= ks[k]; s += bf2f(a[k]) * rbf(w); } return s; }
__device__ __forceinline__ void report(float* slot, float stored, float expect) { const float d = fabsf(stored - expect) / (fabsf(expect) + 0.05f); atomicMax((unsigned*)slot, __float_as_uint(d)); }
__device__ __forceinline__ float sgm(float x) { return 1.f / (1.f + expf(-x)); }
__global__ void chk_p1(const bf16* XN, const float* w_in, const unsigned char* ws, const unsigned char* dob, float* slot) {
    const unsigned s = blockIdx.x * blockDim.x + threadIdx.x; const unsigned hsh = hash_u(s * 2654435761u + 12345u);
    const int arr = s % 7, row = hsh % M, col = (hsh >> 14) % 1024; const bf16* a = XN + (size_t)row * DM;
    float e; const bf16* st;
    switch (arr) {
    case 0: e = dot_bf(a, w_in, NIN, C_AQ + col, 1024, nullptr); st = (const bf16*)(ws + WS_S2); break;
    case 1: e = dot_bf(a, w_in, NIN, C_AV + col, 1024, nullptr); st = (const bf16*)(ws + WS_S3); break;
    case 2: { const float o = dot_bf(a, w_in, NIN, C_AO + col, 1024, nullptr), z = dot_bf(a, w_in, NIN, C_AZ + col, 1024, nullptr); e = sgm(o) * z * sgm(z); st = (const bf16*)(ws + WS_S4); } break;
    case 3: e = dot_bf(a, w_in, NIN, C_BQ + col, 1024, nullptr) * pg8::QSCALE; st = (const bf16*)(ws + WS_S5); break;
    case 4: e = dot_bf(a, w_in, NIN, C_BK + col, 1024, nullptr); st = (const bf16*)(ws + WS_S6); break;
    case 5: e = dot_bf(a, w_in, NIN, C_BV + col, 1024, nullptr); st = (const bf16*)(ws + WS_S7); break;
    default: { const float z = dot_bf(a, w_in, NIN, C_BZ + col, 1024, nullptr); e = z * sgm(z); st = (const bf16*)(dob + DO_SBZ); } break;
    }
    report(slot, bf2f(st[(size_t)row * 1024 + col]), e);
}
__global__ void chk_p3(const bf16* XN, const float* w_in, const bf16* Pb, const float* w_pp, const unsigned char* ws, float* slot) {
    const unsigned s = blockIdx.x * blockDim.x + threadIdx.x; const unsigned hsh = hash_u(s * 2654435761u + 777u);
    const int arr = s % 3, row = hsh % M, col = (hsh >> 14) % 1024; float e; const bf16* st;
    if (arr == 0) { e = sgm(dot_bf(XN + (size_t)row * DM, w_in, NIN, C_GA + col, 1024, nullptr)); st = (const bf16*)(ws + WS_S2); }
    else if (arr == 1) { e = sgm(dot_bf(XN + (size_t)row * DM, w_in, NIN, C_GB + col, 1024, nullptr)); st = (const bf16*)(ws + WS_S3); }
    else { e = dot_bf(Pb + (size_t)row * PLE, w_pp, 1024, col, 256, nullptr); st = (const bf16*)(ws + WS_S6); }
    report(slot + (arr == 0 ? 0 : (arr == 1 ? 5 : 6)), bf2f(st[(size_t)row * 1024 + col]), e);
}
__global__ void chk_p4(const unsigned char* ws, const float* w_in, const float* w_a, const float* w_b, float* slot) {
    const unsigned s = blockIdx.x * blockDim.x + threadIdx.x; const unsigned hsh = hash_u(s * 2654435761u + 999u);
    const int row = hsh % M, col = (hsh >> 14) % 1024; const bf16* XN = (const bf16*)(ws + WS_S1) + (size_t)row * DM;
    const float ga = rbf(sgm(dot_bf(XN, w_in, NIN, C_GA + col, 1024, nullptr))), gb = rbf(sgm(dot_bf(XN, w_in, NIN, C_GB + col, 1024, nullptr)));
    const float ya = dot_bf((const bf16*)(ws + WS_S4) + (size_t)row * DM, w_a, 1024, col, 1024, nullptr), yb = dot_bf((const bf16*)(ws + WS_S5) + (size_t)row * DM, w_b, 1024, col, 1024, nullptr);
    report(slot, bf2f(((const bf16*)(ws + WS_S2))[(size_t)row * 1024 + col]), rbf(ga * ya) + gb * yb);
}
__global__ void chk_p5(const unsigned char* ws, const float* x, const float* w_out, const float* X1, float* slot) {
    const unsigned s = blockIdx.x * blockDim.x + threadIdx.x; const unsigned hsh = hash_u(s * 2654435761u + 4242u);
    const int row = hsh % M, col = (hsh >> 14) % 1024;
    const float e = x[(size_t)row * DM + col] + dot_bf((const bf16*)(ws + WS_S2) + (size_t)row * DM, w_out, 1024, col, 1024, nullptr);
    report(slot, X1[(size_t)row * DM + col], e);
    report(slot, bf2f(((const bf16*)(ws + WS_S1))[(size_t)row * DM + col]), e);
    if ((s & 63) == 0) { float ss = 0.f, sp = 0.f; for (int k = 0; k < DM; ++k) { const float v = X1[(size_t)row * DM + k]; ss += v * v; } for (int k = 0; k < 16; ++k) sp += ((const float*)(ws + WS_S7))[(size_t)row * 16 + k];
        report(slot, sp, ss); }
}
__global__ void chk_p6(const unsigned char* ws, const float* w_pg, const float* gple, const float* X2, float* slot) {
    const unsigned s = blockIdx.x * blockDim.x + threadIdx.x; const unsigned hsh = hash_u(s * 2654435761u + 31337u);
    const int row = hsh % M, col = (hsh >> 14) % 1024; const bf16* xb = (const bf16*)(ws + WS_S1) + (size_t)row * DM;
    float ss = 0.f; for (int k = 0; k < DM; ++k) { const float v = bf2f(xb[k]); ss += v * v; }
    const float rstd = 1.f / sqrtf(ss / DM + EPS);
    const float z = rstd * dot_bf(xb, w_pg, 1024, col, 1024, gple);
    const float e = bf2f(xb[col]) + sgm(z) * bf2f(((const bf16*)(ws + WS_S6))[(size_t)row * DM + col]);
    report(slot, X2[(size_t)row * DM + col], e);
    if ((s & 63) == 0) { float s2 = 0.f, sp = 0.f; for (int k = 0; k < DM; ++k) { const float v = X2[(size_t)row * DM + k]; s2 += v * v; } for (int k = 0; k < 16; ++k) sp += ((const float*)(ws + WS_S7 + MiB))[(size_t)row * 16 + k];
        report(slot, sp, s2); }
}

__global__ void chk_bt3(const bf16* Bt3, const float* w_in, const bf16* GA, const bf16* XN, float* slot) {
    const unsigned s = blockIdx.x * blockDim.x + threadIdx.x; const unsigned hsh = hash_u(s * 2654435761u + 555u);
    unsigned* cnt = (unsigned*)slot;
    { const int row = (hsh % M) | 128, col = (hsh >> 14) % 1024; const float e = sgm(dot_bf(XN + (size_t)row * DM, w_in, NIN, C_GA + col, 1024, nullptr)); const float st = bf2f(GA[(size_t)row * 1024 + col]);
      const float d = fabsf(st - e) / (fabsf(e) + 0.05f);
      atomicAdd(cnt + 0, 1u);
      if (d > 0.03f) { atomicAdd(cnt + 1, 1u); const float e2 = dot_bf(XN + (size_t)row * DM, w_in, NIN, C_AQ + col, 1024, nullptr); if (fabsf(st - e2) / (fabsf(e2) + 0.05f) < 0.03f) atomicAdd(cnt + 2, 1u); } }
}
__global__ void dbg_fill(float* out, const float* slots) {
    float code = 0.f;
    { const int order[6] = {1, 3, 8, 9, 4, 5}; int mask = 0; for (int k = 0; k < 6; ++k) if (slots[order[k]] > 0.03f) mask |= 1 << k; if (slots[6] > 0.03f) mask |= 64; code = 100.f * mask; }
#if DBG >= 10
    code = slots[DBG - 10] * 1e4f;
#endif
    const size_t i = (size_t)blockIdx.x * blockDim.x + threadIdx.x; out[i] = code;
}
#endif
extern "C" void kernel_launch(void* const* d_in, const int* in_sizes, int n_in, void* d_out, int out_size, void* d_ws, size_t ws_size, hipStream_t stream) {
    static int grid = 0;
    if (grid == 0) {
        int dev = 0, cus = 0;
        if (n_in != 17 || out_size != M * DM || ws_size < WS_END) { fprintf(stderr, "kernel_launch: unexpected shapes (n_in %d out %d ws %zu)\n", n_in, out_size, ws_size); grid = -1; return; }
        if (hipGetDevice(&dev) != hipSuccess || hipDeviceGetAttribute(&cus, hipDeviceAttributeMultiprocessorCount, dev) != hipSuccess) { grid = -1; return; }
        if (hipFuncSetAttribute((const void*)fwd, hipFuncAttributeMaxDynamicSharedMemorySize, LDS_BYTES) != hipSuccess) { grid = -1; return; }
        grid = cus;
    }
    if (grid < 0) return;
    (void)hipMemsetAsync((char*)d_ws + WS_CTL, 0, CTL_ZERO_BYTES, stream);
    Args a{};
    for (int i = 0; i < 17; ++i) a.in[i] = (const float*)d_in[i];
    a.out = (float*)d_out; a.ws = (unsigned char*)d_ws;
    unsigned char* ws = (unsigned char*)d_ws; unsigned char* dob = (unsigned char*)d_out;
    auto run = [&](int lo, int hi) { a.ph_lo = lo; a.ph_hi = hi; hipLaunchKernelGGL(fwd, dim3(grid), dim3(NWAVES * 64), LDS_BYTES, stream, a); };
#ifdef DBG
    float* slots = (float*)(ws + 31 * MiB); (void)hipMemsetAsync(slots, 0, 64, stream);
#endif
    run(0, 1);
    hipLaunchKernelGGL(small_gates_naive, dim3(M / 4), dim3(256), 0, stream, (const bf16*)(ws + WS_S1), a.in[3], a.in[6], a.in[7], a.in[9], (float*)(ws + WS_LI), (float*)(ws + WS_LFA), (float*)(ws + WS_LFB));
    run(1, 2);
#ifdef DBG
    hipLaunchKernelGGL(chk_p1, dim3(64), dim3(256), 0, stream, (const bf16*)(ws + WS_S1), a.in[3], (const unsigned char*)ws, (const unsigned char*)dob, slots + 1);
#endif
    hipLaunchKernelGGL(mlstm_naive, dim3(BATCH * 4), dim3(256), 0, stream, (const bf16*)(ws + WS_S2), (const bf16*)(ws + WS_S3), (bf16*)(ws + WS_S4), (const float*)(ws + WS_LI), (const float*)(ws + WS_LFA), a.in[4], a.in[5], a.in[8]);
    hipLaunchKernelGGL(cum_naive, dim3(1), dim3(128), 0, stream, (const float*)(ws + WS_LFB), (float*)(dob + DO_CUMB));
    hipLaunchKernelGGL(attn_naive, dim3(BATCH * 16 * 8), dim3(256), 0, stream, (bf16*)(ws + WS_S5), (const bf16*)(ws + WS_S6), (const bf16*)(ws + WS_S7), (const bf16*)(dob + DO_SBZ), (const float*)(dob + DO_CUMB));
    run(3, 4);
#ifdef DBG
    hipLaunchKernelGGL(chk_bt3, dim3(64), dim3(256), 0, stream, (const bf16*)(ws + WS_BT3), a.in[3], (const bf16*)(ws + WS_S2), (const bf16*)(ws + WS_S1), slots + 10);
    hipLaunchKernelGGL(chk_p3, dim3(64), dim3(256), 0, stream, (const bf16*)(ws + WS_S1), a.in[3], (const bf16*)(dob + DO_PB), a.in[15], (const unsigned char*)ws, slots + 3);
#endif
    run(4, 5);
#ifdef DBG
    hipLaunchKernelGGL(chk_p4, dim3(64), dim3(256), 0, stream, (const unsigned char*)ws, a.in[3], a.in[10], a.in[11], slots + 4);
#endif
    run(5, 6);
#ifdef DBG
    hipLaunchKernelGGL(chk_p5, dim3(64), dim3(256), 0, stream, (const unsigned char*)ws, a.in[0], a.in[12], (const float*)d_out, slots + 5);
#endif
    run(6, 7);
#ifdef DBG
    hipLaunchKernelGGL(chk_p6, dim3(64), dim3(256), 0, stream, (const unsigned char*)ws, a.in[14], a.in[13], (const float*)d_out, slots + 6);
    hipLaunchKernelGGL(dbg_fill, dim3(M * DM / 256), dim3(256), 0, stream, (float*)d_out, (const float*)slots);
    return;
#endif
    hipLaunchKernelGGL(final_naive, dim3(M / 4), dim3(256), 0, stream, (float*)d_out, (const float*)(ws + WS_S7 + MiB), a.in[16]);
}
```

```cpp
#include <hip/hip_runtime.h>
#include <cstdio>
#include <cstdint>
#include <cmath>
__device__ __forceinline__ int lane_now() { int l; asm volatile("s_nop 1\n\tv_mbcnt_lo_u32_b32 %0, -1, 0\n\tv_mbcnt_hi_u32_b32 %0, -1, %0" : "=v"(l)); return l; }
namespace pg8 {
#define PG8_LAS __attribute__((address_space(3)))
typedef unsigned short bf16_t;
typedef short bf16x8 __attribute__((ext_vector_type(8)));
typedef float f32x4 __attribute__((ext_vector_type(4)));
typedef unsigned u32x4 __attribute__((ext_vector_type(4)));
constexpr int BM = 256, BK = 64, HALF = 128, HTB = HALF * BK * 2  , STAGE_BYTES = 8 * HTB, NXCD = 8, WGM = 8;

__host__ __device__ __forceinline__ int lds_byte(int r, int c) { const int st = (r >> 4) * 2 + (c >> 5), rr = r & 15, cc = c & 31, ob = rr * 64 + cc * 2; return st * 1024 + (ob ^ (((ob >> 9) & 1) << 5)); }
__host__ __device__ __forceinline__ void stage_rc(int b, int& R, int& C) { const int st = b / 1024, sb = b % 1024, swz = sb ^ (((sb >> 9) & 1) << 5); R = (st >> 1) * 16 + swz / 64; C = (st & 1) * 32 + (swz % 64) / 2; }
__host__ __device__ __forceinline__ int perm32(int rho) { const int n = rho >> 4, i = rho & 15; return 8 * (i >> 2) + 4 * n + (i & 3); }

struct Unit { int pm, pn; };
struct Gemm { const bf16_t* A; const bf16_t* Bt; int M, N, K; };

struct StaticOrder {
    int nM, nN, nwg, G, c;
    __host__ __device__ void init(int M, int N, int G_, int c_) { nM = M / BM; nN = N / BM; nwg = nM * nN; G = G_; c = c_; }
    __host__ __device__ bool next(int i, Unit& u) const {
        const long L = (long)i * G + c; if (L >= nwg) return false;
        int wgid = (int)L; { const int q = nwg / NXCD, r = nwg % NXCD, xcd = wgid % NXCD, off = wgid / NXCD; wgid = (xcd < r ? xcd * (q + 1) : r * (q + 1) + (xcd - r) * q) + off; }
        const int nig = WGM * nN, gid = wgid / nig, fm = gid * WGM, gsz = (nM - fm) < WGM ? (nM - fm) : WGM;
        u.pm = fm + ((wgid % nig) % gsz); u.pn = (wgid % nig) / gsz; return true;
    }
    __device__ __forceinline__ void a_ready(const Unit&) const {}
    __device__ __forceinline__ void done(const Unit&) const {}
};

typedef unsigned u32x2 __attribute__((ext_vector_type(2)));
typedef float f32x2_t __attribute__((ext_vector_type(2))); typedef __bf16 bf16x2_t __attribute__((ext_vector_type(2)));
__device__ __forceinline__ unsigned cvt_pk_bf16(float lo, float hi) { f32x2_t v = {lo, hi}; bf16x2_t b = __builtin_convertvector(v, bf16x2_t); return __builtin_bit_cast(unsigned, b); }
__device__ __forceinline__ float bf_lo(unsigned w) { return __uint_as_float(w << 16); }
__device__ __forceinline__ float bf_hi(unsigned w) { return __uint_as_float(w & 0xffff0000u); }
__device__ __forceinline__ float sigmoidf_(float x) { return __builtin_amdgcn_rcpf(1.f + __expf(-x)); }
__device__ __forceinline__ float siluf_(float x) { return x * sigmoidf_(x); }
__device__ __forceinline__ u32x4 pack8(const f32x4 a, const f32x4 b) { u32x4 w; w.x = cvt_pk_bf16(a[0], a[1]); w.y = cvt_pk_bf16(a[2], a[3]); w.z = cvt_pk_bf16(b[0], b[1]); w.w = cvt_pk_bf16(b[2], b[3]); return w; }
__device__ __forceinline__ void unpack8(const u32x4 w, f32x4& a, f32x4& b) { a = (f32x4){bf_lo(w.x), bf_hi(w.x), bf_lo(w.y), bf_hi(w.y)}; b = (f32x4){bf_lo(w.z), bf_hi(w.z), bf_lo(w.w), bf_hi(w.w)}; }

constexpr float QSCALE = 0.125f * 1.4426950408889634f;

struct EpiP1 {
    static constexpr bool PERM = true, AFTER_DRAIN = false;
    bf16_t* s2;
    bf16_t* sbz;
    __device__ __forceinline__ void operator()(const f32x4 (&acc)[2][2][4][2], const Unit& u, int wr, int wc, int fr, int fq) const {
        const int grp = u.pn >> 2;
        const int row0 = u.pm * BM + wr * 64 + fr;
        constexpr size_t SLOT = (size_t)16384 * 1024;
        if (grp == 2 || grp == 3) {
            bf16_t* base = s2 + 2 * SLOT; const int col0 = 128 * (u.pn - 8) + wc * 32 + 8 * fq;
#pragma unroll
            for (int ai = 0; ai < 2; ++ai)
#pragma unroll
                for (int m = 0; m < 4; ++m) { bf16_t* rowp = base + (size_t)(row0 + ai * HALF + m * 16) * 1024 + col0;
                    f32x4 r0, r1;
#pragma unroll
                    for (int e = 0; e < 4; ++e) { r0[e] = sigmoidf_(acc[ai][0][m][0][e]) * siluf_(acc[ai][1][m][0][e]); r1[e] = sigmoidf_(acc[ai][0][m][1][e]) * siluf_(acc[ai][1][m][1][e]); }
                    *(u32x4*)rowp = pack8(r0, r1); }
        } else {
            const int sidx = grp < 2 ? grp : grp - 1;
            bf16_t* base = (grp == 7) ? sbz : s2 + (size_t)sidx * SLOT;
            const int col0 = (u.pn & 3) * BM + wc * 32 + 8 * fq;
            const float sc = (grp == 4) ? QSCALE : 1.f;
#pragma unroll
            for (int ai = 0; ai < 2; ++ai)
#pragma unroll
                for (int m = 0; m < 4; ++m) { bf16_t* rowp = base + (size_t)(row0 + ai * HALF + m * 16) * 1024 + col0;
#pragma unroll
                    for (int bj = 0; bj < 2; ++bj) { f32x4 v0 = acc[ai][bj][m][0] * sc, v1 = acc[ai][bj][m][1] * sc;
                        if (grp == 7) {
#pragma unroll
                            for (int e = 0; e < 4; ++e) { v0[e] = siluf_(v0[e]); v1[e] = siluf_(v1[e]); } }
                        *(u32x4*)(rowp + bj * HALF) = pack8(v0, v1); } }
        }
    }
};

template <int ACT  > struct EpiBf16Split {
    static constexpr bool PERM = true, AFTER_DRAIN = false;
    bf16_t* O0; bf16_t* O1;
    __device__ __forceinline__ void operator()(const f32x4 (&acc)[2][2][4][2], const Unit& u, int wr, int wc, int fr, int fq) const {
        const int row0 = u.pm * BM + wr * 64 + fr; bf16_t* base = (u.pn < 4) ? O0 : O1;
        const int col0 = (u.pn & 3) * BM + wc * 32 + 8 * fq;
#pragma unroll
        for (int ai = 0; ai < 2; ++ai)
#pragma unroll
            for (int m = 0; m < 4; ++m) { bf16_t* rowp = base + (size_t)(row0 + ai * HALF + m * 16) * 1024 + col0;
#pragma unroll
                for (int bj = 0; bj < 2; ++bj) { f32x4 v0 = acc[ai][bj][m][0], v1 = acc[ai][bj][m][1];
                    if (ACT == 1) {
#pragma unroll
                        for (int e = 0; e < 4; ++e) { v0[e] = sigmoidf_(v0[e]); v1[e] = sigmoidf_(v1[e]); } }
                    *(u32x4*)(rowp + bj * HALF) = pack8(v0, v1); } }
    }
};

template <int SECOND> struct EpiGate {
    static constexpr bool PERM = true, AFTER_DRAIN = false;
    bf16_t* T; const bf16_t* G2;
    __device__ __forceinline__ void operator()(const f32x4 (&acc)[2][2][4][2], const Unit& u, int wr, int wc, int fr, int fq) const {
        const int row0 = u.pm * BM + wr * 64 + fr; const int col0 = u.pn * BM + wc * 32 + 8 * fq;
#pragma unroll
        for (int ai = 0; ai < 2; ++ai)
#pragma unroll
            for (int m = 0; m < 4; ++m) { const size_t off = (size_t)(row0 + ai * HALF + m * 16) * 1024 + col0;
#pragma unroll
                for (int bj = 0; bj < 2; ++bj) {
                    f32x4 t0, t1; unpack8(*(const u32x4*)(T + off + bj * HALF), t0, t1);
                    f32x4 r0, r1;
                    if (SECOND) { f32x4 g0, g1; unpack8(*(const u32x4*)(G2 + off + bj * HALF), g0, g1); r0 = g0 * acc[ai][bj][m][0] + t0; r1 = g1 * acc[ai][bj][m][1] + t1; }
                    else { r0 = t0 * acc[ai][bj][m][0]; r1 = t1 * acc[ai][bj][m][1]; }
                    *(u32x4*)(T + off + bj * HALF) = pack8(r0, r1); } }
    }
};

struct EpiRes {
    static constexpr bool PERM = false, AFTER_DRAIN = false;
    const float* x; float* X1; bf16_t* XB1; float* SSP;
    __device__ __forceinline__ void operator()(const f32x4 (&acc)[2][2][4][2], const Unit& u, int wr, int wc, int fr, int fq) const {
        const int row0 = u.pm * BM + wr * 64 + fr, col0 = u.pn * BM + wc * 32 + 4 * fq;
#pragma unroll
        for (int ai = 0; ai < 2; ++ai)
#pragma unroll
            for (int m = 0; m < 4; ++m) { const int row = row0 + ai * HALF + m * 16; const size_t off = (size_t)row * 1024 + col0; float ss = 0.f;
#pragma unroll
                for (int bj = 0; bj < 2; ++bj)
#pragma unroll
                    for (int n = 0; n < 2; ++n) { const f32x4 xv = *(const f32x4*)(x + off + bj * HALF + n * 16); const f32x4 v = xv + acc[ai][bj][m][n];
                        *(f32x4*)(X1 + off + bj * HALF + n * 16) = v; ss += (v[0] * v[0] + v[1] * v[1]) + (v[2] * v[2] + v[3] * v[3]);
                        u32x2 w; w.x = cvt_pk_bf16(v[0], v[1]); w.y = cvt_pk_bf16(v[2], v[3]); *(u32x2*)(XB1 + off + bj * HALF + n * 16) = w; }
                ss += __shfl_xor(ss, 16); ss += __shfl_xor(ss, 32);
                if (fq == 0) SSP[(size_t)row * 16 + u.pn * 4 + wc] = ss; }
    }
};

struct EpiPle {
    static constexpr bool PERM = false, AFTER_DRAIN = false;
    float* X; const bf16_t* PP; const float* SSP1; float* SSP2; float eps;
    __device__ __forceinline__ void operator()(const f32x4 (&acc)[2][2][4][2], const Unit& u, int wr, int wc, int fr, int fq) const {
        const int row0 = u.pm * BM + wr * 64 + fr, col0 = u.pn * BM + wc * 32 + 4 * fq;
#pragma unroll
        for (int ai = 0; ai < 2; ++ai)
#pragma unroll
            for (int m = 0; m < 4; ++m) { const int row = row0 + ai * HALF + m * 16; const size_t off = (size_t)row * 1024 + col0;
                const f32x4* sp = (const f32x4*)(SSP1 + (size_t)row * 16); const f32x4 s0 = sp[0], s1 = sp[1], s2 = sp[2], s3 = sp[3];
                const float tot = ((s0[0] + s0[1]) + (s0[2] + s0[3])) + ((s1[0] + s1[1]) + (s1[2] + s1[3])) + ((s2[0] + s2[1]) + (s2[2] + s2[3])) + ((s3[0] + s3[1]) + (s3[2] + s3[3]));
                const float rstd = 1.0f / sqrtf(tot * (1.0f / 1024.0f) + eps); float ss = 0.f;
#pragma unroll
                for (int bj = 0; bj < 2; ++bj)
#pragma unroll
                    for (int n = 0; n < 2; ++n) { const f32x4 xv = *(const f32x4*)(X + off + bj * HALF + n * 16); const u32x2 pw = *(const u32x2*)(PP + off + bj * HALF + n * 16);
                        const f32x4 pp = (f32x4){bf_lo(pw.x), bf_hi(pw.x), bf_lo(pw.y), bf_hi(pw.y)}; f32x4 v;
#pragma unroll
                        for (int e = 0; e < 4; ++e) v[e] = xv[e] + sigmoidf_(rstd * acc[ai][bj][m][n][e]) * pp[e];
                        *(f32x4*)(X + off + bj * HALF + n * 16) = v; ss += (v[0] * v[0] + v[1] * v[1]) + (v[2] * v[2] + v[3] * v[3]); }
                ss += __shfl_xor(ss, 16); ss += __shfl_xor(ss, 32);
                if (fq == 0) SSP2[(size_t)row * 16 + u.pn * 4 + wc] = ss; }
    }
};

template <class Epi, class Sched, bool ALIGN_EPI = false, bool SP2 = false>
__device__ __forceinline__ void gemm_phase(PG8_LAS unsigned char* lds, const Gemm g, const Sched& S, const Epi& E, const int wave_id) {
    const int wid = wave_id, lane = lane_now(), tid = wid * 64 + lane, wr = wid >> 2, wc = wid & 3, fr = lane & 15, fq = lane >> 4;
    const int K = g.K, nt = K / BK;
    unsigned voffA[2], voffB[2];
#pragma unroll
    for (int i = 0; i < 2; ++i) { int R, C; stage_rc(tid * 16 + i * 8192, R, C); const int Rb = Epi::PERM ? ((R & ~31) + perm32(R & 31)) : R;
        voffA[i] = (unsigned)(R * K + C) * 2u; voffB[i] = (unsigned)(Rb * K + C) * 2u; }
    const size_t kstep = (size_t)(BK * 2);
    const size_t hstep = (size_t)HALF * K * 2;
    const size_t tstep = 2 * hstep;
    const unsigned ldsw = (unsigned)wid * 1024u;
    const int aoff = lds_byte(wr * 64 + fr, fq * 8), boff = lds_byte(wc * 32 + fr, fq * 8);
#define PG8_SA(b, h) (((b) * 2 + (h)) * HTB)
#define PG8_SB(b, h) ((4 + (b) * 2 + (h)) * HTB)
#define PG8_STAGE(bufoff, gbase, voff) do { _Pragma("unroll") for (int _i = 0; _i < 2; ++_i) \
        __builtin_amdgcn_global_load_lds((const unsigned*)((const char*)(gbase) + (voff)[_i]), (PG8_LAS unsigned*)(lds + (bufoff) + ldsw + _i * 8192), 16, 0, 0); } while (0)
#define PG8_LDA(dst, b, h) do { _Pragma("unroll") for (int m = 0; m < 4; ++m) _Pragma("unroll") for (int k = 0; k < 2; ++k) dst[m][k] = *(const PG8_LAS bf16x8*)(lds + PG8_SA(b, h) + aoff + m * 2048 + k * 1024); } while (0)
#define PG8_LDB(dst, b, h) do { _Pragma("unroll") for (int n = 0; n < 2; ++n) _Pragma("unroll") for (int k = 0; k < 2; ++k) dst[n][k] = *(const PG8_LAS bf16x8*)(lds + PG8_SB(b, h) + boff + n * 2048 + k * 1024); } while (0)
#define PG8_MMA(ai, bj, At, Bt) do { __builtin_amdgcn_s_setprio(1); _Pragma("unroll") for (int m = 0; m < 4; ++m) _Pragma("unroll") for (int n = 0; n < 2; ++n) _Pragma("unroll") for (int k = 0; k < 2; ++k) \
        acc[ai][bj][m][n] = __builtin_amdgcn_mfma_f32_16x16x32_bf16(Bt[n][k], At[m][k], acc[ai][bj][m][n], 0, 0, 0); __builtin_amdgcn_s_setprio(0); } while (0)
#define PG8_WAIT_V(n) asm volatile("s_waitcnt vmcnt(" #n ")" ::: "memory")
#define PG8_WAIT_L(n) asm volatile("s_waitcnt lgkmcnt(" #n ")" ::: "memory")
#define PG8_BAR __builtin_amdgcn_s_barrier()
#define PG8_SCHED __builtin_amdgcn_sched_barrier(0)
    Unit cur, nxt; int ui = 0;
    if (!S.next(0, cur)) return;
    f32x4 acc[2][2][4][2];
#pragma unroll
    for (int a = 0; a < 2; ++a)
#pragma unroll
        for (int b = 0; b < 2; ++b)
#pragma unroll
            for (int m = 0; m < 4; ++m)
#pragma unroll
                for (int n = 0; n < 2; ++n) acc[a][b][m][n] = (f32x4){0.f, 0.f, 0.f, 0.f};
    bf16x8 At[4][2], B0[2][2], B1[2][2];
    const char* cA = (const char*)g.A + (size_t)cur.pm * tstep; const char* cB = (const char*)g.Bt + (size_t)cur.pn * tstep;
    S.a_ready(cur);
    if constexpr (SP2) {
        PG8_STAGE(PG8_SB(0, 0), cB, voffB); PG8_STAGE(PG8_SB(0, 1), cB + hstep, voffB); PG8_STAGE(PG8_SA(0, 0), cA, voffA); PG8_STAGE(PG8_SA(0, 1), cA + hstep, voffA);
        if (wr == 1) PG8_BAR;
        PG8_WAIT_V(2); PG8_BAR;
        PG8_STAGE(PG8_SB(1, 0), cB + kstep, voffB); PG8_STAGE(PG8_SA(1, 0), cA + kstep, voffA); PG8_STAGE(PG8_SB(1, 1), cB + hstep + kstep, voffB);
        PG8_WAIT_V(6); PG8_BAR;
    } else {
        PG8_STAGE(PG8_SB(0, 0), cB, voffB); PG8_STAGE(PG8_SA(0, 0), cA, voffA); PG8_STAGE(PG8_SB(0, 1), cB + hstep, voffB); PG8_STAGE(PG8_SA(0, 1), cA + hstep, voffA);
        if (wr == 1) PG8_BAR;
        PG8_WAIT_V(4); PG8_BAR;
        PG8_STAGE(PG8_SB(1, 0), cB + kstep, voffB); PG8_STAGE(PG8_SA(1, 0), cA + kstep, voffA); PG8_STAGE(PG8_SB(1, 1), cB + hstep + kstep, voffB);
        PG8_WAIT_V(6); PG8_BAR;
    }
    for (;;) {
        const bool has_next = S.next(ui + 1, nxt);
        const char* nA = has_next ? (const char*)g.A + (size_t)nxt.pm * tstep : cA; const char* nB = has_next ? (const char*)g.Bt + (size_t)nxt.pn * tstep : cB;
        for (int t = 0; t < nt; t += 2) {
            const bool last = (t == nt - 2);
            const char* a1 = cA + (size_t)(t + 1) * kstep;
            const char* a2 = last ? nA : cA + (size_t)(t + 2) * kstep; const char* b2 = last ? nB : cB + (size_t)(t + 2) * kstep;
            const char* a3 = a2 + kstep; const char* b3 = b2 + kstep;
            if (last && has_next) S.a_ready(nxt);
            if constexpr (SP2) {
            PG8_LDB(B0, 0, 0); PG8_LDB(B1, 0, 1); PG8_SCHED; PG8_LDA(At, 0, 0); PG8_STAGE(PG8_SA(1, 1), a1 + hstep, voffA);
            PG8_WAIT_V(8); PG8_WAIT_L(0); PG8_BAR; PG8_MMA(0, 0, At, B0); PG8_MMA(0, 1, At, B1); PG8_BAR; PG8_SCHED;
            PG8_LDA(At, 0, 1); PG8_STAGE(PG8_SB(0, 0), b2, voffB); PG8_STAGE(PG8_SB(0, 1), b2 + hstep, voffB); PG8_STAGE(PG8_SA(0, 0), a2, voffA);
            PG8_WAIT_V(8); PG8_WAIT_L(0); PG8_BAR; PG8_MMA(1, 0, At, B0); PG8_MMA(1, 1, At, B1); PG8_BAR; PG8_SCHED;
            PG8_LDB(B0, 1, 0); PG8_LDB(B1, 1, 1); PG8_SCHED; PG8_LDA(At, 1, 0); PG8_STAGE(PG8_SA(0, 1), a2 + hstep, voffA);
            PG8_WAIT_V(8); PG8_WAIT_L(0); PG8_BAR; PG8_MMA(0, 0, At, B0); PG8_MMA(0, 1, At, B1); PG8_BAR; PG8_SCHED;
            PG8_LDA(At, 1, 1); PG8_STAGE(PG8_SB(1, 0), b3, voffB); PG8_STAGE(PG8_SB(1, 1), b3 + hstep, voffB); PG8_STAGE(PG8_SA(1, 0), a3, voffA);
            PG8_WAIT_V(8); PG8_WAIT_L(0); PG8_BAR; PG8_MMA(1, 0, At, B0); PG8_MMA(1, 1, At, B1); PG8_BAR; PG8_SCHED;
            } else {
            PG8_LDB(B0, 0, 0); PG8_SCHED; PG8_LDA(At, 0, 0); PG8_STAGE(PG8_SA(1, 1), a1 + hstep, voffA);
            PG8_WAIT_L(8); PG8_BAR; PG8_WAIT_L(0); PG8_MMA(0, 0, At, B0); PG8_BAR; PG8_SCHED;
            PG8_LDB(B1, 0, 1); PG8_STAGE(PG8_SB(0, 0), b2, voffB);
            PG8_BAR; PG8_WAIT_L(0); PG8_MMA(0, 1, At, B1); PG8_BAR;
            PG8_LDA(At, 0, 1); PG8_STAGE(PG8_SA(0, 0), a2, voffA);
            PG8_BAR; PG8_WAIT_L(0); PG8_MMA(1, 0, At, B0); PG8_BAR; PG8_SCHED;
            PG8_STAGE(PG8_SB(0, 1), b2 + hstep, voffB);
            PG8_WAIT_V(6); PG8_BAR; PG8_MMA(1, 1, At, B1); PG8_BAR;
            PG8_LDB(B0, 1, 0); PG8_SCHED; PG8_LDA(At, 1, 0); PG8_STAGE(PG8_SA(0, 1), a2 + hstep, voffA);
            PG8_WAIT_L(8); PG8_BAR; PG8_WAIT_L(0); PG8_MMA(0, 0, At, B0); PG8_BAR; PG8_SCHED;
            PG8_LDB(B1, 1, 1); PG8_STAGE(PG8_SB(1, 0), b3, voffB);
            PG8_BAR; PG8_WAIT_L(0); PG8_MMA(0, 1, At, B1); PG8_BAR;
            PG8_LDA(At, 1, 1); PG8_STAGE(PG8_SA(1, 0), a3, voffA);
            PG8_BAR; PG8_WAIT_L(0); PG8_MMA(1, 0, At, B0); PG8_BAR; PG8_SCHED;
            PG8_STAGE(PG8_SB(1, 1), b3 + hstep, voffB);
            PG8_WAIT_V(6); PG8_BAR; PG8_MMA(1, 1, At, B1); PG8_BAR;
            }
        }
        if constexpr (ALIGN_EPI) { if (wr == 0) PG8_BAR; }
        if constexpr (!Epi::AFTER_DRAIN) { E(acc, cur, wr, wc, fr, fq); S.done(cur); }
        if (!has_next) break;
#pragma unroll
        for (int a = 0; a < 2; ++a)
#pragma unroll
            for (int b = 0; b < 2; ++b)
#pragma unroll
                for (int m = 0; m < 4; ++m)
#pragma unroll
                    for (int n = 0; n < 2; ++n) acc[a][b][m][n] = (f32x4){0.f, 0.f, 0.f, 0.f};
        cur = nxt; cA = nA; cB = nB; ++ui;
        if constexpr (ALIGN_EPI) { if (wr == 1) PG8_BAR; }
    }
    PG8_WAIT_V(0);
    if constexpr (!ALIGN_EPI) { if (wr == 0) PG8_BAR; }
    PG8_BAR;
    if constexpr (Epi::AFTER_DRAIN) { E.fused(acc, cur, wr, wc, fr, fq, lds, wid, lane); S.done(cur); }
#undef PG8_SA
#undef PG8_SB
#undef PG8_STAGE
#undef PG8_LDA
#undef PG8_LDB
#undef PG8_MMA
#undef PG8_WAIT_V
#undef PG8_WAIT_L
#undef PG8_BAR
#undef PG8_SCHED
}
}

#ifndef PG8_SP2
#define PG8_SP2 true
#endif
#ifndef PG8_ALIGN
#define PG8_ALIGN true
#endif
#define GAS __attribute__((address_space(1)))
#define LAS __attribute__((address_space(3)))
typedef float f32x4 __attribute__((ext_vector_type(4)));

#define XB_TMO      128
#define XB_XCNT(j)  (256  + 64 * (j))
#define XB_XSUB(j)  (1280 + 64 * (j))
#define XB_XGEN(j)  (2304 + 64 * (j))
#define XB_TOP      3328
#define XB_TOPGEN   3392
#define XCD_BAR_WORDS 3456
#define XB_SPIN_CAP (1u << 18)

__device__ __forceinline__ unsigned xb_ld(unsigned* p)              { return __hip_atomic_load(p, __ATOMIC_RELAXED, __HIP_MEMORY_SCOPE_AGENT); }
__device__ __forceinline__ unsigned xb_add(unsigned* p, unsigned v) { return __hip_atomic_fetch_add(p, v, __ATOMIC_RELAXED, __HIP_MEMORY_SCOPE_AGENT); }
__device__ __forceinline__ unsigned xb_xcc_id() { return (unsigned)__builtin_amdgcn_s_getreg((3 << 11) | 20) & 0xFu; }
#define XB_SPIN(cond, bar) do { unsigned _sp = 0; while (cond) { __builtin_amdgcn_s_sleep(1); \
    if ((++_sp & 255u) == 0u) { if (xb_ld(&(bar)[XB_TMO])) break; if (_sp > XB_SPIN_CAP) { atomicAdd(&(bar)[XB_TMO], 1u); break; } } } } while (0)

struct XcdBarrier { unsigned* bar; unsigned x; volatile LAS unsigned* st; };

__device__ __forceinline__ XcdBarrier xcd_barrier_post(unsigned* bar, volatile LAS unsigned* st, int wave_id) {
    XcdBarrier b; b.bar = bar; b.x = xb_xcc_id(); b.st = st;
    if (wave_id == 0 && lane_now() == 0) (void)xb_add(&bar[XB_XCNT(b.x)], 1u);
    return b;
}
__device__ __forceinline__ void xcd_barrier_complete(unsigned* bar, unsigned x, unsigned& nloc, unsigned& nx) {
    const unsigned G = gridDim.x * gridDim.y * gridDim.z;
    unsigned sum, cnt, mine, sp = 0u;
    for (;;) {
        sum = 0u; cnt = 0u; mine = 0u;
#pragma unroll
        for (unsigned j = 0; j < 16; ++j) { const unsigned c = xb_ld(&bar[XB_XCNT(j)]); sum += c; cnt += (c > 0u) ? 1u : 0u; mine = (j == x) ? c : mine; }
        if (sum == G) break;
        __builtin_amdgcn_s_sleep(1);
        if ((++sp & 255u) == 0u) { if (xb_ld(&bar[XB_TMO])) break; if (sp > XB_SPIN_CAP) { atomicAdd(&bar[XB_TMO], 1u); break; } }
    }
    nloc = mine > 0u ? mine : 1u; nx = cnt > 0u ? cnt : 1u;
}
__device__ __forceinline__ void xcd_barrier(const XcdBarrier& b, int wave_id) {
    asm volatile("s_waitcnt vmcnt(0)" ::: "memory");
    __syncthreads();
    if (wave_id == 0 && lane_now() == 0) {
        unsigned* bar = b.bar;
        __builtin_amdgcn_s_waitcnt(0);
        unsigned nloc = b.st[0], nx = b.st[1];
        if (nloc == 0u) { xcd_barrier_complete(bar, b.x, nloc, nx); b.st[0] = nloc; b.st[1] = nx; }
        const unsigned old = xb_add(&bar[XB_XSUB(b.x)], 1u);
        const unsigned gen = old / nloc;
        if (old + 1u == (gen + 1u) * nloc) {
            __builtin_amdgcn_fence(__ATOMIC_RELEASE, "agent");
            asm volatile("s_waitcnt vmcnt(0)" ::: "memory");
            const unsigned og = xb_add(&bar[XB_TOP], 1u);
            const unsigned tg = og / nx;
            if (og + 1u == (tg + 1u) * nx) xb_add(&bar[XB_TOPGEN], 1u);
            else XB_SPIN(xb_ld(&bar[XB_TOPGEN]) == tg, bar);
            __builtin_amdgcn_fence(__ATOMIC_ACQUIRE, "agent");
            xb_add(&bar[XB_XGEN(b.x)], 1u);
            asm volatile("s_waitcnt vmcnt(0)" ::: "memory");
        } else {
            XB_SPIN(xb_ld(&bar[XB_XGEN(b.x)]) == gen, bar);
            __builtin_amdgcn_fence(__ATOMIC_ACQUIRE, "agent");
            asm volatile("s_waitcnt vmcnt(0)" ::: "memory");
        }
    }
    __syncthreads();
}

constexpr int NWAVES = 8;
constexpr int BATCH = 8, SEQ = 2048, DM = 1024, M = BATCH * SEQ, PLE = 256, NIN = 10264;
constexpr int C_AQ = 0, C_AK = 512, C_AV = 1024, C_AI = 2048, C_AF = 2052, C_AO = 2056, C_AZ = 3080, C_BQ = 4104, C_BK = 5128, C_BV = 6152, C_BF = 7176, C_BZ = 7192, C_GA = 8216, C_GB = 9240;
constexpr float EPS = 1e-6f;
constexpr size_t MiB = 1u << 20;
constexpr size_t WS_CTL = 0, CTL_ZERO_BYTES = 1 * MiB;
constexpr size_t WS_BT1 = 1 * MiB, WS_BT3 = 17 * MiB, WS_WAT = 21 * MiB, WS_WBT = 23 * MiB, WS_WOT = 25 * MiB, WS_WGT = 27 * MiB, WS_WPT = 29 * MiB;
constexpr size_t WS_LI = 29 * MiB + 512 * 1024, WS_LFA = WS_LI + 256 * 1024, WS_LFB = 30 * MiB;
constexpr size_t WS_S1 = 32 * MiB, WS_S2 = 64 * MiB, WS_S3 = 96 * MiB, WS_S4 = 128 * MiB, WS_S5 = 160 * MiB, WS_S6 = 192 * MiB, WS_S7 = 224 * MiB, WS_END = 256 * MiB;
constexpr size_t DO_SBZ = 0, DO_PB = 32 * MiB, DO_CUMB = 40 * MiB;
constexpr int CW_BAR = 4096;
constexpr int LDS_BYTES = 147456, MISC_OFF = 131072 + 320;

typedef unsigned short bf16;
typedef unsigned v4u __attribute__((ext_vector_type(4)));
#define LDS_WAIT() asm volatile("s_waitcnt lgkmcnt(0)" ::: "memory")
__device__ __forceinline__ unsigned f2bf(float f) { unsigned u = __builtin_bit_cast(unsigned, f); return (u + 0x7fffu + ((u >> 16) & 1u)) >> 16; }
__device__ __forceinline__ unsigned pk2(float lo, float hi) { return f2bf(lo) | (f2bf(hi) << 16); }
__device__ __forceinline__ float bf2f(bf16 v) { return __uint_as_float((unsigned)v << 16); }
__device__ __forceinline__ float wave_sum(float v) {
#pragma unroll
    for (int o = 1; o < 64; o <<= 1) v += __shfl_xor(v, o);
    return v;
}

__device__ __forceinline__ int bt1_src_col(int n) {
    const int tile = n >> 8, r = n & 255;
    if (tile < 4) return C_AQ + 256 * tile + r;
    if (tile < 8) return C_AV + 256 * (tile - 4) + r;
    if (tile < 16) { const int t = tile - 8; return r < 128 ? C_AO + 128 * t + r : C_AZ + 128 * t + (r - 128); }
    if (tile < 20) return C_BQ + 256 * (tile - 16) + r;
    if (tile < 24) return C_BK + 256 * (tile - 20) + r;
    if (tile < 28) return C_BV + 256 * (tile - 24) + r;
    return C_BZ + 256 * (tile - 28) + r;
}
__device__ __forceinline__ int bt3_src_col(int n) { return n < 1024 ? C_GA + n : C_GB + (n - 1024); }

__device__ __forceinline__ void transpose_item(const float* W, int ld, int srccol0, int k0, bf16* WT, int K, int dstrow0, const float* kscale, LAS float* scr, int lane) {
#pragma unroll 8
    for (int i = 0; i < 32; ++i) { const int kk = 2 * i + (lane >> 5); float v = W[(size_t)(k0 + kk) * ld + srccol0 + (lane & 31)]; if (kscale) v *= kscale[k0 + kk]; scr[kk * 33 + (lane & 31)] = v; }
    LDS_WAIT(); asm volatile("" ::: "memory");
    const int c = lane & 7;
#pragma unroll
    for (int j = 0; j < 4; ++j) { const int n = (lane >> 3) + 8 * j; const LAS float* s = scr + (8 * c) * 33 + n;
        v4u o; o.x = pk2(s[0 * 33], s[1 * 33]); o.y = pk2(s[2 * 33], s[3 * 33]); o.z = pk2(s[4 * 33], s[5 * 33]); o.w = pk2(s[6 * 33], s[7 * 33]);
        *(GAS v4u*)(WT + (size_t)(dstrow0 + n) * K + k0 + 8 * c) = o; }
    LDS_WAIT(); asm volatile("" ::: "memory");
}

__device__ __forceinline__ float log_sigmoid_f(float z) { return fminf(z, 0.f) - log1pf(expf(-fabsf(z))); }

struct Args { const float* in[17]; float* out; unsigned char* ws; int ph_lo, ph_hi; };

__device__ __forceinline__ void p0_prologue(const Args& a, LAS unsigned char* lds, int gw, int NGW, int wave, int lane) {
    LAS float* scr = (LAS float*)(lds + wave * 16384);
    unsigned char* ws = a.ws;
    const float* w_in = a.in[3];
    constexpr int I1 = 256 * 16, I3 = 64 * 16, IW = 32 * 16, IP = 32 * 4;
    constexpr int NITEMS = I1 + I3 + 4 * IW + IP;
    for (int it = gw; it < NITEMS; it += NGW) {
        int r = it;
        if (r < I1) { const int nb = r >> 4, kb = r & 15; transpose_item(w_in, NIN, bt1_src_col(32 * nb), 64 * kb, (bf16*)(ws + WS_BT1), 1024, 32 * nb, nullptr, scr, lane); continue; } r -= I1;
        if (r < I3) { const int nb = r >> 4, kb = r & 15; transpose_item(w_in, NIN, bt3_src_col(32 * nb), 64 * kb, (bf16*)(ws + WS_BT3), 1024, 32 * nb, nullptr, scr, lane); continue; } r -= I3;
        if (r < IW) { const int nb = r >> 4, kb = r & 15; transpose_item(a.in[10], 1024, 32 * nb, 64 * kb, (bf16*)(ws + WS_WAT), 1024, 32 * nb, nullptr, scr, lane); continue; } r -= IW;
        if (r < IW) { const int nb = r >> 4, kb = r & 15; transpose_item(a.in[11], 1024, 32 * nb, 64 * kb, (bf16*)(ws + WS_WBT), 1024, 32 * nb, nullptr, scr, lane); continue; } r -= IW;
        if (r < IW) { const int nb = r >> 4, kb = r & 15; transpose_item(a.in[12], 1024, 32 * nb, 64 * kb, (bf16*)(ws + WS_WOT), 1024, 32 * nb, nullptr, scr, lane); continue; } r -= IW;
        if (r < IW) { const int nb = r >> 4, kb = r & 15; transpose_item(a.in[14], 1024, 32 * nb, 64 * kb, (bf16*)(ws + WS_WGT), 1024, 32 * nb, a.in[13], scr, lane); continue; } r -= IW;
        { const int nb = r >> 2, kb = r & 3; transpose_item(a.in[15], 1024, 32 * nb, 64 * kb, (bf16*)(ws + WS_WPT), 256, 32 * nb, nullptr, scr, lane); }
    }
    __syncthreads();
    {
        LAS float* wsm = (LAS float*)lds;
        for (int idx = wave * 64 + lane; idx < 24 * 1024; idx += NWAVES * 64) { const int c = idx >> 10, k = idx & 1023;
            const int col = c < 4 ? C_AI + c : (c < 8 ? C_AF + (c - 4) : C_BF + (c - 8)); wsm[idx] = w_in[(size_t)k * NIN + col]; }
    }
    __syncthreads();
    const float* x = a.in[0]; const float* g = a.in[2];
    f32x4 gv[4];
#pragma unroll
    for (int j = 0; j < 4; ++j) gv[j] = ((const f32x4*)g)[lane + 64 * j];
    float* LI = (float*)(ws + WS_LI); float* LFA = (float*)(ws + WS_LFA); float* LFB = (float*)(ws + WS_LFB);
    for (int m = gw; m < M; m += NGW) {
        const GAS f32x4* xr = (const GAS f32x4*)(x + (size_t)m * DM) + lane; f32x4 v[4]; float s = 0.f;
#pragma unroll
        for (int j = 0; j < 4; ++j) { v[j] = xr[64 * j]; s += (v[j].x * v[j].x + v[j].y * v[j].y) + (v[j].z * v[j].z + v[j].w * v[j].w); }
        const float rstd = 1.f / sqrtf(wave_sum(s) * (1.f / DM) + EPS);
        GAS unsigned long long* o8 = (GAS unsigned long long*)(ws + WS_S1 + (size_t)m * DM * 2) + lane;
#pragma unroll
        for (int j = 0; j < 4; ++j) { v[j] = v[j] * rstd * gv[j]; o8[64 * j] = (unsigned long long)pk2(v[j].x, v[j].y) | ((unsigned long long)pk2(v[j].z, v[j].w) << 32); }
        const LAS f32x4* wsm4 = (const LAS f32x4*)lds;
        float mine = 0.f;
#pragma unroll 1
        for (int c = 0; c < 24; ++c) {
            float d = 0.f;
#pragma unroll
            for (int j = 0; j < 4; ++j) { const f32x4 w = wsm4[c * 256 + lane + 64 * j]; d += (v[j].x * w.x + v[j].y * w.y) + (v[j].z * w.z + v[j].w * w.w); }
            d = wave_sum(d);
            if (lane == c) mine = d;
        }
        if (lane < 4) LI[(size_t)m * 4 + lane] = mine + a.in[6][lane];
        else if (lane < 8) LFA[(size_t)m * 4 + (lane - 4)] = log_sigmoid_f(mine + a.in[7][lane - 4]);
        else if (lane < 24) LFB[(size_t)m * 16 + (lane - 8)] = log_sigmoid_f(mine + a.in[9][lane - 8]);
    }
    const float* p = a.in[1];
    for (int m = gw; m < M; m += NGW) {
        const f32x4 v = ((const GAS f32x4*)(p + (size_t)m * PLE))[lane];
        ((GAS unsigned long long*)((unsigned char*)a.out + DO_PB + (size_t)m * PLE * 2))[lane] = (unsigned long long)pk2(v.x, v.y) | ((unsigned long long)pk2(v.z, v.w) << 32);
    }
}


__device__ __forceinline__ void cum_scan_unit(const float* LFB, float* CUMB, int bh, int lane) {
    const int b = bh >> 4, h = bh & 15; float v[32]; float run = 0.f;
#pragma unroll
    for (int i = 0; i < 32; ++i) { run += LFB[((size_t)b * SEQ + 32 * lane + i) * 16 + h]; v[i] = run; }
    float incl = run;
#pragma unroll
    for (int o = 1; o < 64; o <<= 1) { const float y = __shfl_up(incl, o); if (lane >= o) incl += y; }
    const float excl = incl - run;
#pragma unroll
    for (int i = 0; i < 32; ++i) CUMB[(size_t)bh * SEQ + 32 * lane + i] = v[i] + excl;
}

__device__ __forceinline__ void mlstm_unit_naive(const bf16* AQK, const bf16* AV, bf16* GATEA_HA, const float* LI, const float* LFA, const float* conv_w, const float* conv_b, const float* hn_g,
                                                 LAS unsigned char* lds, int unit, int tid) {
    const int b = unit >> 2, h = unit & 3, v = tid & 255, half = tid >> 8;
    LAS float* qs = (LAS float*)lds; LAS float* ks = qs + 128; LAS float* nump = ks + 128; LAS float* red = nump + 256; LAS float* red2 = red + 8;
    float C[64];
#pragma unroll
    for (int d = 0; d < 64; ++d) C[d] = 0.f;
    float nreg = 0.f, mst = 0.f;
    const int ch = (v < 128) ? (h * 128 + v) : (512 + h * 128 + (v - 128));
    const float w0 = conv_w[0 * 1024 + ch], w1 = conv_w[1 * 1024 + ch], w2 = conv_w[2 * 1024 + ch], w3 = conv_w[3 * 1024 + ch], cb = conv_b[ch];
    float x0 = 0.f, x1 = 0.f, x2 = 0.f;
    const float hg = hn_g[h * 256 + v];
    for (int t = 0; t < SEQ; ++t) {
        const size_t row = (size_t)b * SEQ + t;
        if (half == 0) {
            const float x3 = bf2f(AQK[row * 1024 + ch]);
            float y = x0 * w0 + x1 * w1 + x2 * w2 + x3 * w3 + cb; x0 = x1; x1 = x2; x2 = x3;
            y = y / (1.f + expf(-y));
            if (v < 128) qs[v] = y; else ks[v - 128] = y * 0.08838834764831845f;
        }
        __syncthreads();
        const float li = LI[row * 4 + h], lf = LFA[row * 4 + h];
        const float mnew = fmaxf(lf + mst, li), fs = expf(lf + mst - mnew), is = expf(li - mnew); mst = mnew;
        const float vt = bf2f(AV[row * 1024 + h * 256 + v]);
        float num = 0.f; const float iv = is * vt;
#pragma unroll
        for (int d = 0; d < 64; ++d) { C[d] = fs * C[d] + iv * ks[64 * half + d]; num += qs[64 * half + d] * C[d]; }
        float dp = 0.f;
        if (tid < 128) { nreg = fs * nreg + is * ks[tid]; dp = nreg * qs[tid]; }
        dp = wave_sum(dp);
        if ((tid & 63) == 0) red[tid >> 6] = dp;
        if (half == 1) nump[v] = num;
        __syncthreads();
        float hval = 0.f;
        if (half == 0) { num += nump[v]; const float den = red[0] + red[1]; hval = num / fmaxf(fabsf(den), expf(-mnew)); }
        const float sq = wave_sum(hval * hval);
        if ((tid & 63) == 0) red2[tid >> 6] = sq;
        __syncthreads();
        if (half == 0) {
            const float ms = (red2[0] + red2[1] + red2[2] + red2[3]) * (1.f / 256.f);
            const size_t o = row * 1024 + h * 256 + v;
            GATEA_HA[o] = (bf16)f2bf(hval * (1.f / sqrtf(ms + EPS)) * hg * bf2f(GATEA_HA[o]));
        }
    }
    __syncthreads();
}

__device__ __forceinline__ void attn_unit_naive(bf16* BQ_HB, const bf16* BK, const bf16* BV, const bf16* SBZ, const float* CUMB, LAS unsigned char* lds, int unit, int tid) {
    const int bh = unit >> 2, qb = unit & 3, b = bh >> 4, h = bh & 15, tq = qb * 512 + tid;
    LAS float* Ks = (LAS float*)lds; LAS float* Vs = Ks + 64 * 65; LAS float* cs = Vs + 64 * 65;
    const size_t rowq = (size_t)b * SEQ + tq;
    float q[64], o[64];
#pragma unroll
    for (int d = 0; d < 64; ++d) { q[d] = bf2f(BQ_HB[rowq * 1024 + h * 64 + d]); o[d] = 0.f; }
    const float L2E = 1.4426950408889634f;
    const float cq = CUMB[(size_t)bh * SEQ + tq] * L2E;
    float mrun = -INFINITY, l = 0.f;
    const int ntile = (qb * 512 + 512) / 64;
    for (int kt = 0; kt < ntile; ++kt) {
        __syncthreads();
        for (int i = tid; i < 64 * 64; i += 512) { const int r = i >> 6, d = i & 63; const size_t rk = ((size_t)b * SEQ + kt * 64 + r) * 1024 + h * 64 + d; Ks[r * 65 + d] = bf2f(BK[rk]); Vs[r * 65 + d] = bf2f(BV[rk]); }
        if (tid < 64) cs[tid] = CUMB[(size_t)bh * SEQ + kt * 64 + tid] * L2E;
        __syncthreads();
        for (int r = 0; r < 64; ++r) {
            const int tk = kt * 64 + r; if (tk > tq) break;
            float sc = 0.f;
#pragma unroll
            for (int d = 0; d < 64; ++d) sc += q[d] * Ks[r * 65 + d];
            sc += cq - cs[r];
            if (sc > mrun) { const float f = exp2f(mrun - sc); l *= f;
#pragma unroll
                for (int d = 0; d < 64; ++d) o[d] *= f;
                mrun = sc; }
            const float pexp = exp2f(sc - mrun); l += pexp;
#pragma unroll
            for (int d = 0; d < 64; ++d) o[d] += pexp * Vs[r * 65 + d];
        }
    }
    const float inv = 1.f / l;
#pragma unroll
    for (int d = 0; d < 64; ++d) { const size_t oo = rowq * 1024 + h * 64 + d; BQ_HB[oo] = (bf16)f2bf(o[d] * inv * bf2f(SBZ[oo])); }
    __syncthreads();
}

__global__ void __launch_bounds__(NWAVES * 64, 2) fwd(Args args) {
    extern __shared__ __attribute__((aligned(16))) unsigned char lds_raw[];
    LAS unsigned char* lds = (LAS unsigned char*)lds_raw;
    const int wave = __builtin_amdgcn_readfirstlane(threadIdx.x >> 6);
    const int G = gridDim.x;
    volatile LAS unsigned* MISC = (volatile LAS unsigned*)(lds + MISC_OFF);
    for (int u = wave * 64 + lane_now(); u < (LDS_BYTES - 131072) / 4; u += NWAVES * 64) ((LAS unsigned*)(lds + 131072))[u] = 0u;
    __syncthreads();
    unsigned char* ws = args.ws;
    unsigned* ctl = (unsigned*)ws;
    const int lo = args.ph_lo, hi = args.ph_hi;
    XcdBarrier bar; bar.bar = ctl + CW_BAR; bar.x = 0; bar.st = nullptr;
    if (hi - lo > 1) bar = xcd_barrier_post(ctl + CW_BAR, MISC + 8, wave);
#define IN(k) (lo <= (k) && (k) < hi)
#define BOTH(k) (IN(k) && IN((k) + 1))
    using pg8::bf16_t;
    bf16_t* S1 = (bf16_t*)(ws + WS_S1); bf16_t* S2 = (bf16_t*)(ws + WS_S2); bf16_t* S3 = (bf16_t*)(ws + WS_S3); bf16_t* S4 = (bf16_t*)(ws + WS_S4);
    bf16_t* S5 = (bf16_t*)(ws + WS_S5); bf16_t* S6 = (bf16_t*)(ws + WS_S6);
    float* SSP1 = (float*)(ws + WS_S7); float* SSP2 = (float*)(ws + WS_S7 + MiB);

    if (IN(0)) { p0_prologue(args, lds, (int)blockIdx.x * NWAVES + wave, G * NWAVES, wave, lane_now()); if (BOTH(0)) xcd_barrier(bar, wave); }

    if (IN(1)) {
        if (wave == 0 && blockIdx.x < BATCH * 16) cum_scan_unit((const float*)(ws + WS_LFB), (float*)((unsigned char*)args.out + DO_CUMB), (int)blockIdx.x, lane_now());
        pg8::Gemm g{S1, (const bf16_t*)(ws + WS_BT1), M, 8192, 1024}; pg8::StaticOrder S; S.init(M, 8192, G, (int)blockIdx.x);
        pg8::EpiP1 E{S2, (bf16_t*)((unsigned char*)args.out + DO_SBZ)};
        pg8::gemm_phase<pg8::EpiP1, pg8::StaticOrder, PG8_ALIGN, PG8_SP2>(lds, g, S, E, wave);
        if (BOTH(1)) xcd_barrier(bar, wave);
    }
    if (IN(2)) {
        const int tid = wave * 64 + lane_now();
        if (blockIdx.x < BATCH * 4) mlstm_unit_naive((const bf16*)S2, (const bf16*)S3, (bf16*)S4, (const float*)(ws + WS_LI), (const float*)(ws + WS_LFA), args.in[4], args.in[5], args.in[8], lds, (int)blockIdx.x, tid);
        else for (int u = (int)blockIdx.x - BATCH * 4; u < BATCH * 16 * 4; u += G - BATCH * 4)
            attn_unit_naive((bf16*)S5, (const bf16*)S6, (const bf16*)(ws + WS_S7), (const bf16*)((unsigned char*)args.out + DO_SBZ), (const float*)((unsigned char*)args.out + DO_CUMB), lds, u, tid);
        if (BOTH(2)) xcd_barrier(bar, wave);
    }
    if (IN(3)) {
        { pg8::Gemm g{S1, (const bf16_t*)(ws + WS_BT3), M, 2048, 1024}; pg8::StaticOrder S; S.init(M, 2048, G, (int)blockIdx.x);
          pg8::EpiBf16Split<1> E{S2, S3};
          pg8::gemm_phase<pg8::EpiBf16Split<1>, pg8::StaticOrder, PG8_ALIGN, PG8_SP2>(lds, g, S, E, wave); }
        { int kpp = 256; asm volatile("" : "+s"(kpp));
          pg8::Gemm g{(const bf16_t*)((unsigned char*)args.out + DO_PB), (const bf16_t*)(ws + WS_WPT), M, 1024, kpp}; pg8::StaticOrder S; S.init(M, 1024, G, (int)blockIdx.x);
          pg8::EpiBf16Split<0> E{S6, S6};
          pg8::gemm_phase<pg8::EpiBf16Split<0>, pg8::StaticOrder, PG8_ALIGN, PG8_SP2>(lds, g, S, E, wave); }
        if (BOTH(3)) xcd_barrier(bar, wave);
    }
    if (IN(4)) {
        { pg8::Gemm g{S4, (const bf16_t*)(ws + WS_WAT), M, 1024, 1024}; pg8::StaticOrder S; S.init(M, 1024, G, (int)blockIdx.x);
          pg8::EpiGate<0> E{S2, nullptr};
          pg8::gemm_phase<pg8::EpiGate<0>, pg8::StaticOrder, false, PG8_SP2>(lds, g, S, E, wave); }
        { pg8::Gemm g{S5, (const bf16_t*)(ws + WS_WBT), M, 1024, 1024}; pg8::StaticOrder S; S.init(M, 1024, G, (int)blockIdx.x);
          pg8::EpiGate<1> E{S2, S3};
          pg8::gemm_phase<pg8::EpiGate<1>, pg8::StaticOrder, false, PG8_SP2>(lds, g, S, E, wave); }
        if (BOTH(4)) xcd_barrier(bar, wave);
    }
    if (IN(5)) {
        pg8::Gemm g{S2, (const bf16_t*)(ws + WS_WOT), M, 1024, 1024}; pg8::StaticOrder S; S.init(M, 1024, G, (int)blockIdx.x);
        pg8::EpiRes E{args.in[0], args.out, S1, SSP1};
        pg8::gemm_phase<pg8::EpiRes, pg8::StaticOrder, false, PG8_SP2>(lds, g, S, E, wave);
        if (BOTH(5)) xcd_barrier(bar, wave);
    }
    if (IN(6)) {
        pg8::Gemm g{S1, (const bf16_t*)(ws + WS_WGT), M, 1024, 1024}; pg8::StaticOrder S; S.init(M, 1024, G, (int)blockIdx.x);
        pg8::EpiPle E{args.out, S6, SSP1, SSP2, EPS};
        pg8::gemm_phase<pg8::EpiPle, pg8::StaticOrder, false, PG8_SP2>(lds, g, S, E, wave);
        if (BOTH(6)) xcd_barrier(bar, wave);
    }
    if (IN(7)) {
        const int lane = lane_now(); const float* gf = args.in[16];
        for (int m = (int)blockIdx.x * NWAVES + wave; m < M; m += G * NWAVES) {
            const f32x4* sp = (const f32x4*)(SSP2 + (size_t)m * 16); const f32x4 s0 = sp[0], s1 = sp[1], s2 = sp[2], s3 = sp[3];
            const float tot = ((s0[0] + s0[1]) + (s0[2] + s0[3])) + ((s1[0] + s1[1]) + (s1[2] + s1[3])) + ((s2[0] + s2[1]) + (s2[2] + s2[3])) + ((s3[0] + s3[1]) + (s3[2] + s3[3]));
            const float rstd = 1.f / sqrtf(tot * (1.f / DM) + EPS);
            f32x4* xr = (f32x4*)(args.out + (size_t)m * DM) + lane;
#pragma unroll
            for (int j = 0; j < 4; ++j) { const f32x4 gv = ((const f32x4*)gf)[lane + 64 * j]; xr[64 * j] = xr[64 * j] * rstd * gv; }
        }
    }
#undef IN
#undef BOTH
}


__global__ void __launch_bounds__(256) small_gates_naive(const bf16* XN, const float* w_in, const float* bias_i, const float* bias_fa, const float* bias_fb, float* LI, float* LFA, float* LFB) {
    const int lane = threadIdx.x & 63, row = blockIdx.x * 4 + (threadIdx.x >> 6);
    float xv[16];
#pragma unroll
    for (int i = 0; i < 16; ++i) xv[i] = bf2f(XN[(size_t)row * DM + lane + 64 * i]);
    for (int c = 0; c < 24; ++c) {
        const int col = c < 4 ? C_AI + c : (c < 8 ? C_AF + (c - 4) : C_BF + (c - 8));
        float s = 0.f;
#pragma unroll
        for (int i = 0; i < 16; ++i) s += xv[i] * w_in[(size_t)(lane + 64 * i) * NIN + col];
        s = wave_sum(s);
        if (lane == 0) {
            if (c < 4) LI[(size_t)row * 4 + c] = s + bias_i[c];
            else if (c < 8) LFA[(size_t)row * 4 + (c - 4)] = log_sigmoid_f(s + bias_fa[c - 4]);
            else LFB[(size_t)row * 16 + (c - 8)] = log_sigmoid_f(s + bias_fb[c - 8]);
        }
    }
}

__global__ void __launch_bounds__(256) mlstm_naive(const bf16* AQK, const bf16* AV, bf16* GATEA_HA, const float* LI, const float* LFA, const float* conv_w, const float* conv_b, const float* hn_g) {
    const int b = blockIdx.x >> 2, h = blockIdx.x & 3, v = threadIdx.x;
    __shared__ float qs[128], ks[128], red[8], red2[8];
    float C[128];
#pragma unroll
    for (int d = 0; d < 128; ++d) C[d] = 0.f;
    float nreg = 0.f, mst = 0.f;
    const int ch = (v < 128) ? (h * 128 + v) : (512 + h * 128 + (v - 128));
    const float w0 = conv_w[0 * 1024 + ch], w1 = conv_w[1 * 1024 + ch], w2 = conv_w[2 * 1024 + ch], w3 = conv_w[3 * 1024 + ch], cb = conv_b[ch];
    float x0 = 0.f, x1 = 0.f, x2 = 0.f;
    const float hg = hn_g[h * 256 + v];
    for (int t = 0; t < SEQ; ++t) {
        const size_t row = (size_t)b * SEQ + t;
        const float x3 = bf2f(AQK[row * 1024 + ch]);
        float y = x0 * w0 + x1 * w1 + x2 * w2 + x3 * w3 + cb; x0 = x1; x1 = x2; x2 = x3;
        y = y / (1.f + expf(-y));
        if (v < 128) qs[v] = y; else ks[v - 128] = y * 0.08838834764831845f;
        __syncthreads();
        const float li = LI[row * 4 + h], lf = LFA[row * 4 + h];
        const float mnew = fmaxf(lf + mst, li), fs = expf(lf + mst - mnew), is = expf(li - mnew); mst = mnew;
        const float vt = bf2f(AV[row * 1024 + h * 256 + v]);
        float num = 0.f; const float iv = is * vt;
#pragma unroll
        for (int d = 0; d < 128; ++d) { C[d] = fs * C[d] + iv * ks[d]; num += qs[d] * C[d]; }
        float dp = 0.f;
        if (v < 128) { nreg = fs * nreg + is * ks[v]; dp = nreg * qs[v]; }
        dp = wave_sum(dp);
        if ((v & 63) == 0) red[v >> 6] = dp;
        __syncthreads();
        const float den = red[0] + red[1] + red[2] + red[3];
        const float hval = num / fmaxf(fabsf(den), expf(-mnew));
        float sq = wave_sum(hval * hval);
        if ((v & 63) == 0) red2[v >> 6] = sq;
        __syncthreads();
        const float ms = (red2[0] + red2[1] + red2[2] + red2[3]) * (1.f / 256.f);
        const size_t o = row * 1024 + h * 256 + v;
        const float outv = hval * (1.f / sqrtf(ms + EPS)) * hg * bf2f(GATEA_HA[o]);
        GATEA_HA[o] = (bf16)f2bf(outv);
    }
}

__global__ void cum_naive(const float* LFB, float* CUMB) {
    const int i = blockIdx.x * blockDim.x + threadIdx.x; if (i >= BATCH * 16) return;
    const int b = i >> 4, h = i & 15; float s = 0.f;
    for (int t = 0; t < SEQ; ++t) { s += LFB[((size_t)b * SEQ + t) * 16 + h]; CUMB[(size_t)i * SEQ + t] = s; }
}

__global__ void __launch_bounds__(256) attn_naive(bf16* BQ_HB, const bf16* BK, const bf16* BV, const bf16* SBZ, const float* CUMB) {
    const int bh = blockIdx.x >> 3, qb = blockIdx.x & 7, b = bh >> 4, h = bh & 15, tq = qb * 256 + threadIdx.x;
    __shared__ float Ks[64][65], Vs[64][65], cs[64];
    const size_t rowq = (size_t)b * SEQ + tq;
    float q[64], o[64];
#pragma unroll
    for (int d = 0; d < 64; ++d) { q[d] = bf2f(BQ_HB[rowq * 1024 + h * 64 + d]); o[d] = 0.f; }
    const float L2E = 1.4426950408889634f;
    const float cq = CUMB[(size_t)bh * SEQ + tq] * L2E;
    float mrun = -INFINITY, l = 0.f;
    const int ntile = (qb * 256 + 256) / 64;
    for (int kt = 0; kt < ntile; ++kt) {
        __syncthreads();
        for (int i = threadIdx.x; i < 64 * 64; i += 256) { const int r = i >> 6, d = i & 63; const size_t rk = ((size_t)b * SEQ + kt * 64 + r) * 1024 + h * 64 + d; Ks[r][d] = bf2f(BK[rk]); Vs[r][d] = bf2f(BV[rk]); }
        if (threadIdx.x < 64) cs[threadIdx.x] = CUMB[(size_t)bh * SEQ + kt * 64 + threadIdx.x] * L2E;
        __syncthreads();
        for (int r = 0; r < 64; ++r) {
            const int tk = kt * 64 + r; if (tk > tq) break;
            float s = 0.f;
#pragma unroll
            for (int d = 0; d < 64; ++d) s += q[d] * Ks[r][d];
            s += cq - cs[r];
            if (s > mrun) { const float f = exp2f(mrun - s); l *= f;
#pragma unroll
                for (int d = 0; d < 64; ++d) o[d] *= f;
                mrun = s; }
            const float pexp = exp2f(s - mrun); l += pexp;
#pragma unroll
            for (int d = 0; d < 64; ++d) o[d] += pexp * Vs[r][d];
        }
    }
    const float inv = 1.f / l;
#pragma unroll
    for (int d = 0; d < 64; ++d) { const size_t oo = rowq * 1024 + h * 64 + d; BQ_HB[oo] = (bf16)f2bf(o[d] * inv * bf2f(SBZ[oo])); }
}

__global__ void __launch_bounds__(256) final_naive(float* X, const float* SSP2, const float* g) {
    const int lane = threadIdx.x & 63, row = blockIdx.x * 4 + (threadIdx.x >> 6);
    float tot = 0.f;
    for (int i = 0; i < 16; ++i) tot += SSP2[(size_t)row * 16 + i];
    const float rstd = 1.f / sqrtf(tot * (1.f / DM) + EPS);
    f32x4* xr = (f32x4*)(X + (size_t)row * DM) + lane;
#pragma unroll
    for (int j = 0; j < 4; ++j) { const f32x4 gv = ((const f32x4*)g)[lane + 64 * j]; xr[64 * j] = xr[64 * j] * rstd * gv; }
}


#ifdef DBG
__device__ __forceinline__ unsigned hash_u(unsigned x) { x ^= x >> 16; x *= 0x7feb352du; x ^= x >> 15; x *= 0x846ca68bu; x ^= x >> 16; return x; }
__device__ __forceinline__ float rbf(float f) { return __uint_as_float(f2bf(f) << 16); }
__device__ __forceinline__ float dot_bf(const bf16* a, const float* W, int ld, int col, int K, const float* ks) {
    float s = 0.f; for (int k = 0; k < K; ++k) { float w = W[(size_t)k * ld + col]; if (ks) w *= ks[k]; s += bf2f(a[k]) * rbf(w); } return s; }
__device__ __forceinline__ void report(float* slot, float stored, float expect) { const float d = fabsf(stored - expect) / (fabsf(expect) + 0.05f); atomicMax((unsigned*)slot, __float_as_uint(d)); }
__device__ __forceinline__ float sgm(float x) { return 1.f / (1.f + expf(-x)); }
__global__ void chk_p1(const bf16* XN, const float* w_in, const unsigned char* ws, const unsigned char* dob, float* slot) {
    const unsigned s = blockIdx.x * blockDim.x + threadIdx.x; const unsigned hsh = hash_u(s * 2654435761u + 12345u);
    const int arr = s % 7, row = hsh % M, col = (hsh >> 14) % 1024; const bf16* a = XN + (size_t)row * DM;
    float e; const bf16* st;
    switch (arr) {
    case 0: e = dot_bf(a, w_in, NIN, C_AQ + col, 1024, nullptr); st = (const bf16*)(ws + WS_S2); break;
    case 1: e = dot_bf(a, w_in, NIN, C_AV + col, 1024, nullptr); st = (const bf16*)(ws + WS_S3); break;
    case 2: { const float o = dot_bf(a, w_in, NIN, C_AO + col, 1024, nullptr), z = dot_bf(a, w_in, NIN, C_AZ + col, 1024, nullptr); e = sgm(o) * z * sgm(z); st = (const bf16*)(ws + WS_S4); } break;
    case 3: e = dot_bf(a, w_in, NIN, C_BQ + col, 1024, nullptr) * pg8::QSCALE; st = (const bf16*)(ws + WS_S5); break;
    case 4: e = dot_bf(a, w_in, NIN, C_BK + col, 1024, nullptr); st = (const bf16*)(ws + WS_S6); break;
    case 5: e = dot_bf(a, w_in, NIN, C_BV + col, 1024, nullptr); st = (const bf16*)(ws + WS_S7); break;
    default: { const float z = dot_bf(a, w_in, NIN, C_BZ + col, 1024, nullptr); e = z * sgm(z); st = (const bf16*)(dob + DO_SBZ); } break;
    }
    report(slot, bf2f(st[(size_t)row * 1024 + col]), e);
}
__global__ void chk_p3(const bf16* XN, const float* w_in, const bf16* Pb, const float* w_pp, const unsigned char* ws, float* slot) {
    const unsigned s = blockIdx.x * blockDim.x + threadIdx.x; const unsigned hsh = hash_u(s * 2654435761u + 777u);
    const int arr = s % 3, row = hsh % M, col = (hsh >> 14) % 1024; float e; const bf16* st;
    if (arr == 0) { e = sgm(dot_bf(XN + (size_t)row * DM, w_in, NIN, C_GA + col, 1024, nullptr)); st = (const bf16*)(ws + WS_S2); }
    else if (arr == 1) { e = sgm(dot_bf(XN + (size_t)row * DM, w_in, NIN, C_GB + col, 1024, nullptr)); st = (const bf16*)(ws + WS_S3); }
    else { e = dot_bf(Pb + (size_t)row * PLE, w_pp, 1024, col, 256, nullptr); st = (const bf16*)(ws + WS_S6); }
    report(slot + (arr == 0 ? 0 : (arr == 1 ? 5 : 6)), bf2f(st[(size_t)row * 1024 + col]), e);
}
__global__ void chk_p4(const unsigned char* ws, const float* w_in, const float* w_a, const float* w_b, float* slot) {
    const unsigned s = blockIdx.x * blockDim.x + threadIdx.x; const unsigned hsh = hash_u(s * 2654435761u + 999u);
    const int row = hsh % M, col = (hsh >> 14) % 1024; const bf16* XN = (const bf16*)(ws + WS_S1) + (size_t)row * DM;
    const float ga = rbf(sgm(dot_bf(XN, w_in, NIN, C_GA + col, 1024, nullptr))), gb = rbf(sgm(dot_bf(XN, w_in, NIN, C_GB + col, 1024, nullptr)));
    const float ya = dot_bf((const bf16*)(ws + WS_S4) + (size_t)row * DM, w_a, 1024, col, 1024, nullptr), yb = dot_bf((const bf16*)(ws + WS_S5) + (size_t)row * DM, w_b, 1024, col, 1024, nullptr);
    report(slot, bf2f(((const bf16*)(ws + WS_S2))[(size_t)row * 1024 + col]), rbf(ga * ya) + gb * yb);
}
__global__ void chk_p5(const unsigned char* ws, const float* x, const float* w_out, const float* X1, float* slot) {
    const unsigned s = blockIdx.x * blockDim.x + threadIdx.x; const unsigned hsh = hash_u(s * 2654435761u + 4242u);
    const int row = hsh % M, col = (hsh >> 14) % 1024;
    const float e = x[(size_t)row * DM + col] + dot_bf((const bf16*)(ws + WS_S2) + (size_t)row * DM, w_out, 1024, col, 1024, nullptr);
    report(slot, X1[(size_t)row * DM + col], e);
    report(slot, bf2f(((const bf16*)(ws + WS_S1))[(size_t)row * DM + col]), e);
    if ((s & 63) == 0) { float ss = 0.f, sp = 0.f; for (int k = 0; k < DM; ++k) { const float v = X1[(size_t)row * DM + k]; ss += v * v; } for (int k = 0; k < 16; ++k) sp += ((const float*)(ws + WS_S7))[(size_t)row * 16 + k];
        report(slot, sp, ss); }
}
__global__ void chk_p6(const unsigned char* ws, const float* w_pg, const float* gple, const float* X2, float* slot) {
    const unsigned s = blockIdx.x * blockDim.x + threadIdx.x; const unsigned hsh = hash_u(s * 2654435761u + 31337u);
    const int row = hsh % M, col = (hsh >> 14) % 1024; const bf16* xb = (const bf16*)(ws + WS_S1) + (size_t)row * DM;
    float ss = 0.f; for (int k = 0; k < DM; ++k) { const float v = bf2f(xb[k]); ss += v * v; }
    const float rstd = 1.f / sqrtf(ss / DM + EPS);
    const float z = rstd * dot_bf(xb, w_pg, 1024, col, 1024, gple);
    const float e = bf2f(xb[col]) + sgm(z) * bf2f(((const bf16*)(ws + WS_S6))[(size_t)row * DM + col]);
    report(slot, X2[(size_t)row * DM + col], e);
    if ((s & 63) == 0) { float s2 = 0.f, sp = 0.f; for (int k = 0; k < DM; ++k) { const float v = X2[(size_t)row * DM + k]; s2 += v * v; } for (int k = 0; k < 16; ++k) sp += ((const float*)(ws + WS_S7 + MiB))[(size_t)row * 16 + k];
        report(slot, sp, s2); }
}

__global__ void chk_bt3(const bf16* Bt3, const float* w_in, const bf16* GA, const bf16* XN, float* slot) {
    const unsigned s = blockIdx.x * blockDim.x + threadIdx.x; const unsigned hsh = hash_u(s * 2654435761u + 555u);
    unsigned* cnt = (unsigned*)slot;
    { const int row = (hsh % M) | 128, col = (hsh >> 14) % 1024; const float e = sgm(dot_bf(XN + (size_t)row * DM, w_in, NIN, C_GA + col, 1024, nullptr)); const float st = bf2f(GA[(size_t)row * 1024 + col]);
      const float d = fabsf(st - e) / (fabsf(e) + 0.05f);
      atomicAdd(cnt + 0, 1u);
      if (d > 0.03f) { atomicAdd(cnt + 1, 1u); const float e2 = dot_bf(XN + (size_t)row * DM, w_in, NIN, C_AQ + col, 1024, nullptr); if (fabsf(st - e2) / (fabsf(e2) + 0.05f) < 0.03f) atomicAdd(cnt + 2, 1u); } }
}
__global__ void dbg_fill(float* out, const float* slots) {
    float code = 0.f;
    { const int order[6] = {1, 3, 8, 9, 4, 5}; int mask = 0; for (int k = 0; k < 6; ++k) if (slots[order[k]] > 0.03f) mask |= 1 << k; if (slots[6] > 0.03f) mask |= 64; code = 100.f * mask; }
#if DBG >= 10
    code = slots[DBG - 10] * 1e4f;
#endif
    const size_t i = (size_t)blockIdx.x * blockDim.x + threadIdx.x; out[i] = code;
}
#endif
extern "C" void kernel_launch(void* const* d_in, const int* in_sizes, int n_in, void* d_out, int out_size, void* d_ws, size_t ws_size, hipStream_t stream) {
    static int grid = 0;
    if (grid == 0) {
        int dev = 0, cus = 0;
        if (n_in != 17 || out_size != M * DM || ws_size < WS_END) { fprintf(stderr, "kernel_launch: unexpected shapes (n_in %d out %d ws %zu)\n", n_in, out_size, ws_size); grid = -1; return; }
        if (hipGetDevice(&dev) != hipSuccess || hipDeviceGetAttribute(&cus, hipDeviceAttributeMultiprocessorCount, dev) != hipSuccess) { grid = -1; return; }
        if (hipFuncSetAttribute((const void*)fwd, hipFuncAttributeMaxDynamicSharedMemorySize, LDS_BYTES) != hipSuccess) { grid = -1; return; }
        grid = cus;
    }
    if (grid < 0) return;
    (void)hipMemsetAsync((char*)d_ws + WS_CTL, 0, CTL_ZERO_BYTES, stream);
    Args a{};
    for (int i = 0; i < 17; ++i) a.in[i] = (const float*)d_in[i];
    a.out = (float*)d_out; a.ws = (unsigned char*)d_ws;
    unsigned char* ws = (unsigned char*)d_ws; unsigned char* dob = (unsigned char*)d_out;
    a.ph_lo = 0; a.ph_hi = 8;
    hipLaunchKernelGGL(fwd, dim3(grid), dim3(NWAVES * 64), LDS_BYTES, stream, a);
}
```

```cpp
#include <hip/hip_runtime.h>
#include <cstdio>
#include <cstdint>
#include <cmath>
__device__ __forceinline__ int lane_now() { int l; asm volatile("s_nop 1\n\tv_mbcnt_lo_u32_b32 %0, -1, 0\n\tv_mbcnt_hi_u32_b32 %0, -1, %0" : "=v"(l)); return l; }
namespace pg8 {
#define PG8_LAS __attribute__((address_space(3)))
typedef unsigned short bf16_t;
typedef short bf16x8 __attribute__((ext_vector_type(8)));
typedef float f32x4 __attribute__((ext_vector_type(4)));
typedef unsigned u32x4 __attribute__((ext_vector_type(4)));
constexpr int BM = 256, BK = 64, HALF = 128, HTB = HALF * BK * 2  , STAGE_BYTES = 8 * HTB, NXCD = 8, WGM = 8;

__host__ __device__ __forceinline__ int lds_byte(int r, int c) { const int st = (r >> 4) * 2 + (c >> 5), rr = r & 15, cc = c & 31, ob = rr * 64 + cc * 2; return st * 1024 + (ob ^ (((ob >> 9) & 1) << 5)); }
__host__ __device__ __forceinline__ void stage_rc(int b, int& R, int& C) { const int st = b / 1024, sb = b % 1024, swz = sb ^ (((sb >> 9) & 1) << 5); R = (st >> 1) * 16 + swz / 64; C = (st & 1) * 32 + (swz % 64) / 2; }
__host__ __device__ __forceinline__ int perm32(int rho) { const int n = rho >> 4, i = rho & 15; return 8 * (i >> 2) + 4 * n + (i & 3); }

struct Unit { int pm, pn; };
struct Gemm { const bf16_t* A; const bf16_t* Bt; int M, N, K; };

struct StaticOrder {
    int nM, nN, nwg, G, c;
    __host__ __device__ void init(int M, int N, int G_, int c_) { nM = M / BM; nN = N / BM; nwg = nM * nN; G = G_; c = c_; }
    __host__ __device__ bool next(int i, Unit& u) const {
        const long L = (long)i * G + c; if (L >= nwg) return false;
        int wgid = (int)L; { const int q = nwg / NXCD, r = nwg % NXCD, xcd = wgid % NXCD, off = wgid / NXCD; wgid = (xcd < r ? xcd * (q + 1) : r * (q + 1) + (xcd - r) * q) + off; }
        const int nig = WGM * nN, gid = wgid / nig, fm = gid * WGM, gsz = (nM - fm) < WGM ? (nM - fm) : WGM;
        u.pm = fm + ((wgid % nig) % gsz); u.pn = (wgid % nig) / gsz; return true;
    }
    __device__ __forceinline__ void a_ready(const Unit&) const {}
    __device__ __forceinline__ void done(const Unit&) const {}
};

typedef unsigned u32x2 __attribute__((ext_vector_type(2)));
typedef float f32x2_t __attribute__((ext_vector_type(2))); typedef __bf16 bf16x2_t __attribute__((ext_vector_type(2)));
__device__ __forceinline__ unsigned cvt_pk_bf16(float lo, float hi) { f32x2_t v = {lo, hi}; bf16x2_t b = __builtin_convertvector(v, bf16x2_t); return __builtin_bit_cast(unsigned, b); }
__device__ __forceinline__ float bf_lo(unsigned w) { return __uint_as_float(w << 16); }
__device__ __forceinline__ float bf_hi(unsigned w) { return __uint_as_float(w & 0xffff0000u); }
__device__ __forceinline__ float sigmoidf_(float x) { return __builtin_amdgcn_rcpf(1.f + __expf(-x)); }
__device__ __forceinline__ float siluf_(float x) { return x * sigmoidf_(x); }
__device__ __forceinline__ u32x4 pack8(const f32x4 a, const f32x4 b) { u32x4 w; w.x = cvt_pk_bf16(a[0], a[1]); w.y = cvt_pk_bf16(a[2], a[3]); w.z = cvt_pk_bf16(b[0], b[1]); w.w = cvt_pk_bf16(b[2], b[3]); return w; }
__device__ __forceinline__ void unpack8(const u32x4 w, f32x4& a, f32x4& b) { a = (f32x4){bf_lo(w.x), bf_hi(w.x), bf_lo(w.y), bf_hi(w.y)}; b = (f32x4){bf_lo(w.z), bf_hi(w.z), bf_lo(w.w), bf_hi(w.w)}; }

constexpr float QSCALE = 0.125f * 1.4426950408889634f;

struct EpiP1 {
    static constexpr bool PERM = true, AFTER_DRAIN = false;
    bf16_t* s2;
    bf16_t* sbz;
    __device__ __forceinline__ void operator()(const f32x4 (&acc)[2][2][4][2], const Unit& u, int wr, int wc, int fr, int fq) const {
        const int grp = u.pn >> 2;
        const int row0 = u.pm * BM + wr * 64 + fr;
        constexpr size_t SLOT = (size_t)16384 * 1024;
        if (grp == 2 || grp == 3) {
            bf16_t* base = s2 + 2 * SLOT; const int col0 = 128 * (u.pn - 8) + wc * 32 + 8 * fq;
#pragma unroll
            for (int ai = 0; ai < 2; ++ai)
#pragma unroll
                for (int m = 0; m < 4; ++m) { bf16_t* rowp = base + (size_t)(row0 + ai * HALF + m * 16) * 1024 + col0;
                    f32x4 r0, r1;
#pragma unroll
                    for (int e = 0; e < 4; ++e) { r0[e] = sigmoidf_(acc[ai][0][m][0][e]) * siluf_(acc[ai][1][m][0][e]); r1[e] = sigmoidf_(acc[ai][0][m][1][e]) * siluf_(acc[ai][1][m][1][e]); }
                    *(u32x4*)rowp = pack8(r0, r1); }
        } else {
            const int sidx = grp < 2 ? grp : grp - 1;
            bf16_t* base = (grp == 7) ? sbz : s2 + (size_t)sidx * SLOT;
            const int col0 = (u.pn & 3) * BM + wc * 32 + 8 * fq;
            const float sc = (grp == 4) ? QSCALE : 1.f;
#pragma unroll
            for (int ai = 0; ai < 2; ++ai)
#pragma unroll
                for (int m = 0; m < 4; ++m) { bf16_t* rowp = base + (size_t)(row0 + ai * HALF + m * 16) * 1024 + col0;
#pragma unroll
                    for (int bj = 0; bj < 2; ++bj) { f32x4 v0 = acc[ai][bj][m][0] * sc, v1 = acc[ai][bj][m][1] * sc;
                        if (grp == 7) {
#pragma unroll
                            for (int e = 0; e < 4; ++e) { v0[e] = siluf_(v0[e]); v1[e] = siluf_(v1[e]); } }
                        *(u32x4*)(rowp + bj * HALF) = pack8(v0, v1); } }
        }
    }
};

template <int ACT  > struct EpiBf16Split {
    static constexpr bool PERM = true, AFTER_DRAIN = false;
    bf16_t* O0; bf16_t* O1;
    __device__ __forceinline__ void operator()(const f32x4 (&acc)[2][2][4][2], const Unit& u, int wr, int wc, int fr, int fq) const {
        const int row0 = u.pm * BM + wr * 64 + fr; bf16_t* base = (u.pn < 4) ? O0 : O1;
        const int col0 = (u.pn & 3) * BM + wc * 32 + 8 * fq;
#pragma unroll
        for (int ai = 0; ai < 2; ++ai)
#pragma unroll
            for (int m = 0; m < 4; ++m) { bf16_t* rowp = base + (size_t)(row0 + ai * HALF + m * 16) * 1024 + col0;
#pragma unroll
                for (int bj = 0; bj < 2; ++bj) { f32x4 v0 = acc[ai][bj][m][0], v1 = acc[ai][bj][m][1];
                    if (ACT == 1) {
#pragma unroll
                        for (int e = 0; e < 4; ++e) { v0[e] = sigmoidf_(v0[e]); v1[e] = sigmoidf_(v1[e]); } }
                    *(u32x4*)(rowp + bj * HALF) = pack8(v0, v1); } }
    }
};

template <int SECOND> struct EpiGate {
    static constexpr bool PERM = true, AFTER_DRAIN = false;
    bf16_t* T; const bf16_t* G2;
    __device__ __forceinline__ void operator()(const f32x4 (&acc)[2][2][4][2], const Unit& u, int wr, int wc, int fr, int fq) const {
        const int row0 = u.pm * BM + wr * 64 + fr; const int col0 = u.pn * BM + wc * 32 + 8 * fq;
#pragma unroll
        for (int ai = 0; ai < 2; ++ai)
#pragma unroll
            for (int m = 0; m < 4; ++m) { const size_t off = (size_t)(row0 + ai * HALF + m * 16) * 1024 + col0;
#pragma unroll
                for (int bj = 0; bj < 2; ++bj) {
                    f32x4 t0, t1; unpack8(*(const u32x4*)(T + off + bj * HALF), t0, t1);
                    f32x4 r0, r1;
                    if (SECOND) { f32x4 g0, g1; unpack8(*(const u32x4*)(G2 + off + bj * HALF), g0, g1); r0 = g0 * acc[ai][bj][m][0] + t0; r1 = g1 * acc[ai][bj][m][1] + t1; }
                    else { r0 = t0 * acc[ai][bj][m][0]; r1 = t1 * acc[ai][bj][m][1]; }
                    *(u32x4*)(T + off + bj * HALF) = pack8(r0, r1); } }
    }
};

struct EpiRes {
    static constexpr bool PERM = false, AFTER_DRAIN = false;
    const float* x; float* X1; bf16_t* XB1; float* SSP;
    __device__ __forceinline__ void operator()(const f32x4 (&acc)[2][2][4][2], const Unit& u, int wr, int wc, int fr, int fq) const {
        const int row0 = u.pm * BM + wr * 64 + fr, col0 = u.pn * BM + wc * 32 + 4 * fq;
#pragma unroll
        for (int ai = 0; ai < 2; ++ai)
#pragma unroll
            for (int m = 0; m < 4; ++m) { const int row = row0 + ai * HALF + m * 16; const size_t off = (size_t)row * 1024 + col0; float ss = 0.f;
#pragma unroll
                for (int bj = 0; bj < 2; ++bj)
#pragma unroll
                    for (int n = 0; n < 2; ++n) { const f32x4 xv = *(const f32x4*)(x + off + bj * HALF + n * 16); const f32x4 v = xv + acc[ai][bj][m][n];
                        *(f32x4*)(X1 + off + bj * HALF + n * 16) = v; ss += (v[0] * v[0] + v[1] * v[1]) + (v[2] * v[2] + v[3] * v[3]);
                        u32x2 w; w.x = cvt_pk_bf16(v[0], v[1]); w.y = cvt_pk_bf16(v[2], v[3]); *(u32x2*)(XB1 + off + bj * HALF + n * 16) = w; }
                ss += __shfl_xor(ss, 16); ss += __shfl_xor(ss, 32);
                if (fq == 0) SSP[(size_t)row * 16 + u.pn * 4 + wc] = ss; }
    }
};

struct EpiPle {
    static constexpr bool PERM = false, AFTER_DRAIN = false;
    float* X; const bf16_t* PP; const float* SSP1; float* SSP2; float eps;
    __device__ __forceinline__ void operator()(const f32x4 (&acc)[2][2][4][2], const Unit& u, int wr, int wc, int fr, int fq) const {
        const int row0 = u.pm * BM + wr * 64 + fr, col0 = u.pn * BM + wc * 32 + 4 * fq;
#pragma unroll
        for (int ai = 0; ai < 2; ++ai)
#pragma unroll
            for (int m = 0; m < 4; ++m) { const int row = row0 + ai * HALF + m * 16; const size_t off = (size_t)row * 1024 + col0;
                const f32x4* sp = (const f32x4*)(SSP1 + (size_t)row * 16); const f32x4 s0 = sp[0], s1 = sp[1], s2 = sp[2], s3 = sp[3];
                const float tot = ((s0[0] + s0[1]) + (s0[2] + s0[3])) + ((s1[0] + s1[1]) + (s1[2] + s1[3])) + ((s2[0] + s2[1]) + (s2[2] + s2[3])) + ((s3[0] + s3[1]) + (s3[2] + s3[3]));
                const float rstd = 1.0f / sqrtf(tot * (1.0f / 1024.0f) + eps); float ss = 0.f;
#pragma unroll
                for (int bj = 0; bj < 2; ++bj)
#pragma unroll
                    for (int n = 0; n < 2; ++n) { const f32x4 xv = *(const f32x4*)(X + off + bj * HALF + n * 16); const u32x2 pw = *(const u32x2*)(PP + off + bj * HALF + n * 16);
                        const f32x4 pp = (f32x4){bf_lo(pw.x), bf_hi(pw.x), bf_lo(pw.y), bf_hi(pw.y)}; f32x4 v;
#pragma unroll
                        for (int e = 0; e < 4; ++e) v[e] = xv[e] + sigmoidf_(rstd * acc[ai][bj][m][n][e]) * pp[e];
                        *(f32x4*)(X + off + bj * HALF + n * 16) = v; ss += (v[0] * v[0] + v[1] * v[1]) + (v[2] * v[2] + v[3] * v[3]); }
                ss += __shfl_xor(ss, 16); ss += __shfl_xor(ss, 32);
                if (fq == 0) SSP2[(size_t)row * 16 + u.pn * 4 + wc] = ss; }
    }
};

template <class Epi, class Sched, bool ALIGN_EPI = false, bool SP2 = false>
__device__ __forceinline__ void gemm_phase(PG8_LAS unsigned char* lds, const Gemm g, const Sched& S, const Epi& E, const int wave_id) {
    const int wid = wave_id, lane = lane_now(), tid = wid * 64 + lane, wr = wid >> 2, wc = wid & 3, fr = lane & 15, fq = lane >> 4;
    const int K = g.K, nt = K / BK;
    unsigned voffA[2], voffB[2];
#pragma unroll
    for (int i = 0; i < 2; ++i) { int R, C; stage_rc(tid * 16 + i * 8192, R, C); const int Rb = Epi::PERM ? ((R & ~31) + perm32(R & 31)) : R;
        voffA[i] = (unsigned)(R * K + C) * 2u; voffB[i] = (unsigned)(Rb * K + C) * 2u; }
    const size_t kstep = (size_t)(BK * 2);
    const size_t hstep = (size_t)HALF * K * 2;
    const size_t tstep = 2 * hstep;
    const unsigned ldsw = (unsigned)wid * 1024u;
    const int aoff = lds_byte(wr * 64 + fr, fq * 8), boff = lds_byte(wc * 32 + fr, fq * 8);
#define PG8_SA(b, h) (((b) * 2 + (h)) * HTB)
#define PG8_SB(b, h) ((4 + (b) * 2 + (h)) * HTB)
#define PG8_STAGE(bufoff, gbase, voff) do { _Pragma("unroll") for (int _i = 0; _i < 2; ++_i) \
        __builtin_amdgcn_global_load_lds((const unsigned*)((const char*)(gbase) + (voff)[_i]), (PG8_LAS unsigned*)(lds + (bufoff) + ldsw + _i * 8192), 16, 0, 0); } while (0)
#define PG8_LDA(dst, b, h) do { _Pragma("unroll") for (int m = 0; m < 4; ++m) _Pragma("unroll") for (int k = 0; k < 2; ++k) dst[m][k] = *(const PG8_LAS bf16x8*)(lds + PG8_SA(b, h) + aoff + m * 2048 + k * 1024); } while (0)
#define PG8_LDB(dst, b, h) do { _Pragma("unroll") for (int n = 0; n < 2; ++n) _Pragma("unroll") for (int k = 0; k < 2; ++k) dst[n][k] = *(const PG8_LAS bf16x8*)(lds + PG8_SB(b, h) + boff + n * 2048 + k * 1024); } while (0)
#define PG8_MMA(ai, bj, At, Bt) do { __builtin_amdgcn_s_setprio(1); _Pragma("unroll") for (int m = 0; m < 4; ++m) _Pragma("unroll") for (int n = 0; n < 2; ++n) _Pragma("unroll") for (int k = 0; k < 2; ++k) \
        acc[ai][bj][m][n] = __builtin_amdgcn_mfma_f32_16x16x32_bf16(Bt[n][k], At[m][k], acc[ai][bj][m][n], 0, 0, 0); __builtin_amdgcn_s_setprio(0); } while (0)
#define PG8_WAIT_V(n) asm volatile("s_waitcnt vmcnt(" #n ")" ::: "memory")
#define PG8_WAIT_L(n) asm volatile("s_waitcnt lgkmcnt(" #n ")" ::: "memory")
#define PG8_BAR __builtin_amdgcn_s_barrier()
#define PG8_SCHED __builtin_amdgcn_sched_barrier(0)
    Unit cur, nxt; int ui = 0;
    if (!S.next(0, cur)) return;
    f32x4 acc[2][2][4][2];
#pragma unroll
    for (int a = 0; a < 2; ++a)
#pragma unroll
        for (int b = 0; b < 2; ++b)
#pragma unroll
            for (int m = 0; m < 4; ++m)
#pragma unroll
                for (int n = 0; n < 2; ++n) acc[a][b][m][n] = (f32x4){0.f, 0.f, 0.f, 0.f};
    bf16x8 At[4][2], B0[2][2], B1[2][2];
    const char* cA = (const char*)g.A + (size_t)cur.pm * tstep; const char* cB = (const char*)g.Bt + (size_t)cur.pn * tstep;
    S.a_ready(cur);
    if constexpr (SP2) {
        PG8_STAGE(PG8_SB(0, 0), cB, voffB); PG8_STAGE(PG8_SB(0, 1), cB + hstep, voffB); PG8_STAGE(PG8_SA(0, 0), cA, voffA); PG8_STAGE(PG8_SA(0, 1), cA + hstep, voffA);
        if (wr == 1) PG8_BAR;
        PG8_WAIT_V(2); PG8_BAR;
        PG8_STAGE(PG8_SB(1, 0), cB + kstep, voffB); PG8_STAGE(PG8_SA(1, 0), cA + kstep, voffA); PG8_STAGE(PG8_SB(1, 1), cB + hstep + kstep, voffB);
        PG8_WAIT_V(6); PG8_BAR;
    } else {
        PG8_STAGE(PG8_SB(0, 0), cB, voffB); PG8_STAGE(PG8_SA(0, 0), cA, voffA); PG8_STAGE(PG8_SB(0, 1), cB + hstep, voffB); PG8_STAGE(PG8_SA(0, 1), cA + hstep, voffA);
        if (wr == 1) PG8_BAR;
        PG8_WAIT_V(4); PG8_BAR;
        PG8_STAGE(PG8_SB(1, 0), cB + kstep, voffB); PG8_STAGE(PG8_SA(1, 0), cA + kstep, voffA); PG8_STAGE(PG8_SB(1, 1), cB + hstep + kstep, voffB);
        PG8_WAIT_V(6); PG8_BAR;
    }
    for (;;) {
        const bool has_next = S.next(ui + 1, nxt);
        const char* nA = has_next ? (const char*)g.A + (size_t)nxt.pm * tstep : cA; const char* nB = has_next ? (const char*)g.Bt + (size_t)nxt.pn * tstep : cB;
        for (int t = 0; t < nt; t += 2) {
            const bool last = (t == nt - 2);
            const char* a1 = cA + (size_t)(t + 1) * kstep;
            const char* a2 = last ? nA : cA + (size_t)(t + 2) * kstep; const char* b2 = last ? nB : cB + (size_t)(t + 2) * kstep;
            const char* a3 = a2 + kstep; const char* b3 = b2 + kstep;
            if (last && has_next) S.a_ready(nxt);
            if constexpr (SP2) {
            PG8_LDB(B0, 0, 0); PG8_LDB(B1, 0, 1); PG8_SCHED; PG8_LDA(At, 0, 0); PG8_STAGE(PG8_SA(1, 1), a1 + hstep, voffA);
            PG8_WAIT_V(8); PG8_WAIT_L(0); PG8_BAR; PG8_MMA(0, 0, At, B0); PG8_MMA(0, 1, At, B1); PG8_BAR; PG8_SCHED;
            PG8_LDA(At, 0, 1); PG8_STAGE(PG8_SB(0, 0), b2, voffB); PG8_STAGE(PG8_SB(0, 1), b2 + hstep, voffB); PG8_STAGE(PG8_SA(0, 0), a2, voffA);
            PG8_WAIT_V(8); PG8_WAIT_L(0); PG8_BAR; PG8_MMA(1, 0, At, B0); PG8_MMA(1, 1, At, B1); PG8_BAR; PG8_SCHED;
            PG8_LDB(B0, 1, 0); PG8_LDB(B1, 1, 1); PG8_SCHED; PG8_LDA(At, 1, 0); PG8_STAGE(PG8_SA(0, 1), a2 + hstep, voffA);
            PG8_WAIT_V(8); PG8_WAIT_L(0); PG8_BAR; PG8_MMA(0, 0, At, B0); PG8_MMA(0, 1, At, B1); PG8_BAR; PG8_SCHED;
            PG8_LDA(At, 1, 1); PG8_STAGE(PG8_SB(1, 0), b3, voffB); PG8_STAGE(PG8_SB(1, 1), b3 + hstep, voffB); PG8_STAGE(PG8_SA(1, 0), a3, voffA);
            PG8_WAIT_V(8); PG8_WAIT_L(0); PG8_BAR; PG8_MMA(1, 0, At, B0); PG8_MMA(1, 1, At, B1); PG8_BAR; PG8_SCHED;
            } else {
            PG8_LDB(B0, 0, 0); PG8_SCHED; PG8_LDA(At, 0, 0); PG8_STAGE(PG8_SA(1, 1), a1 + hstep, voffA);
            PG8_WAIT_L(8); PG8_BAR; PG8_WAIT_L(0); PG8_MMA(0, 0, At, B0); PG8_BAR; PG8_SCHED;
            PG8_LDB(B1, 0, 1); PG8_STAGE(PG8_SB(0, 0), b2, voffB);
            PG8_BAR; PG8_WAIT_L(0); PG8_MMA(0, 1, At, B1); PG8_BAR;
            PG8_LDA(At, 0, 1); PG8_STAGE(PG8_SA(0, 0), a2, voffA);
            PG8_BAR; PG8_WAIT_L(0); PG8_MMA(1, 0, At, B0); PG8_BAR; PG8_SCHED;
            PG8_STAGE(PG8_SB(0, 1), b2 + hstep, voffB);
            PG8_WAIT_V(6); PG8_BAR; PG8_MMA(1, 1, At, B1); PG8_BAR;
            PG8_LDB(B0, 1, 0); PG8_SCHED; PG8_LDA(At, 1, 0); PG8_STAGE(PG8_SA(0, 1), a2 + hstep, voffA);
            PG8_WAIT_L(8); PG8_BAR; PG8_WAIT_L(0); PG8_MMA(0, 0, At, B0); PG8_BAR; PG8_SCHED;
            PG8_LDB(B1, 1, 1); PG8_STAGE(PG8_SB(1, 0), b3, voffB);
            PG8_BAR; PG8_WAIT_L(0); PG8_MMA(0, 1, At, B1); PG8_BAR;
            PG8_LDA(At, 1, 1); PG8_STAGE(PG8_SA(1, 0), a3, voffA);
            PG8_BAR; PG8_WAIT_L(0); PG8_MMA(1, 0, At, B0); PG8_BAR; PG8_SCHED;
            PG8_STAGE(PG8_SB(1, 1), b3 + hstep, voffB);
            PG8_WAIT_V(6); PG8_BAR; PG8_MMA(1, 1, At, B1); PG8_BAR;
            }
        }
        if constexpr (ALIGN_EPI) { if (wr == 0) PG8_BAR; }
        if constexpr (!Epi::AFTER_DRAIN) { E(acc, cur, wr, wc, fr, fq); S.done(cur); }
        if (!has_next) break;
#pragma unroll
        for (int a = 0; a < 2; ++a)
#pragma unroll
            for (int b = 0; b < 2; ++b)
#pragma unroll
                for (int m = 0; m < 4; ++m)
#pragma unroll
                    for (int n = 0; n < 2; ++n) acc[a][b][m][n] = (f32x4){0.f, 0.f, 0.f, 0.f};
        cur = nxt; cA = nA; cB = nB; ++ui;
        if constexpr (ALIGN_EPI) { if (wr == 1) PG8_BAR; }
    }
    PG8_WAIT_V(0);
    if constexpr (!ALIGN_EPI) { if (wr == 0) PG8_BAR; }
    PG8_BAR;
    if constexpr (Epi::AFTER_DRAIN) { E.fused(acc, cur, wr, wc, fr, fq, lds, wid, lane); S.done(cur); }
#undef PG8_SA
#undef PG8_SB
#undef PG8_STAGE
#undef PG8_LDA
#undef PG8_LDB
#undef PG8_MMA
#undef PG8_WAIT_V
#undef PG8_WAIT_L
#undef PG8_BAR
#undef PG8_SCHED
}
}

#ifndef PG8_SP2
#define PG8_SP2 true
#endif
#ifndef PG8_ALIGN
#define PG8_ALIGN true
#endif
#define GAS __attribute__((address_space(1)))
#define LAS __attribute__((address_space(3)))
typedef float f32x4 __attribute__((ext_vector_type(4)));

#define XB_TMO      128
#define XB_XCNT(j)  (256  + 64 * (j))
#define XB_XSUB(j)  (1280 + 64 * (j))
#define XB_XGEN(j)  (2304 + 64 * (j))
#define XB_TOP      3328
#define XB_TOPGEN   3392
#define XCD_BAR_WORDS 3456
#define XB_SPIN_CAP (1u << 18)

__device__ __forceinline__ unsigned xb_ld(unsigned* p)              { return __hip_atomic_load(p, __ATOMIC_RELAXED, __HIP_MEMORY_SCOPE_AGENT); }
__device__ __forceinline__ unsigned xb_add(unsigned* p, unsigned v) { return __hip_atomic_fetch_add(p, v, __ATOMIC_RELAXED, __HIP_MEMORY_SCOPE_AGENT); }
__device__ __forceinline__ unsigned xb_xcc_id() { return (unsigned)__builtin_amdgcn_s_getreg((3 << 11) | 20) & 0xFu; }
#define XB_SPIN(cond, bar) do { unsigned _sp = 0; while (cond) { __builtin_amdgcn_s_sleep(1); \
    if ((++_sp & 255u) == 0u) { if (xb_ld(&(bar)[XB_TMO])) break; if (_sp > XB_SPIN_CAP) { atomicAdd(&(bar)[XB_TMO], 1u); break; } } } } while (0)

struct XcdBarrier { unsigned* bar; unsigned x; volatile LAS unsigned* st; };

__device__ __forceinline__ XcdBarrier xcd_barrier_post(unsigned* bar, volatile LAS unsigned* st, int wave_id) {
    XcdBarrier b; b.bar = bar; b.x = xb_xcc_id(); b.st = st;
    if (wave_id == 0 && lane_now() == 0) (void)xb_add(&bar[XB_XCNT(b.x)], 1u);
    return b;
}
__device__ __forceinline__ void xcd_barrier_complete(unsigned* bar, unsigned x, unsigned& nloc, unsigned& nx) {
    const unsigned G = gridDim.x * gridDim.y * gridDim.z;
    unsigned sum, cnt, mine, sp = 0u;
    for (;;) {
        sum = 0u; cnt = 0u; mine = 0u;
#pragma unroll
        for (unsigned j = 0; j < 16; ++j) { const unsigned c = xb_ld(&bar[XB_XCNT(j)]); sum += c; cnt += (c > 0u) ? 1u : 0u; mine = (j == x) ? c : mine; }
        if (sum == G) break;
        __builtin_amdgcn_s_sleep(1);
        if ((++sp & 255u) == 0u) { if (xb_ld(&bar[XB_TMO])) break; if (sp > XB_SPIN_CAP) { atomicAdd(&bar[XB_TMO], 1u); break; } }
    }
    nloc = mine > 0u ? mine : 1u; nx = cnt > 0u ? cnt : 1u;
}
__device__ __forceinline__ void xcd_barrier(const XcdBarrier& b, int wave_id) {
    asm volatile("s_waitcnt vmcnt(0)" ::: "memory");
    __syncthreads();
    if (wave_id == 0 && lane_now() == 0) {
        unsigned* bar = b.bar;
        __builtin_amdgcn_s_waitcnt(0);
        unsigned nloc = b.st[0], nx = b.st[1];
        if (nloc == 0u) { xcd_barrier_complete(bar, b.x, nloc, nx); b.st[0] = nloc; b.st[1] = nx; }
        const unsigned old = xb_add(&bar[XB_XSUB(b.x)], 1u);
        const unsigned gen = old / nloc;
        if (old + 1u == (gen + 1u) * nloc) {
            __builtin_amdgcn_fence(__ATOMIC_RELEASE, "agent");
            asm volatile("s_waitcnt vmcnt(0)" ::: "memory");
            const unsigned og = xb_add(&bar[XB_TOP], 1u);
            const unsigned tg = og / nx;
            if (og + 1u == (tg + 1u) * nx) xb_add(&bar[XB_TOPGEN], 1u);
            else XB_SPIN(xb_ld(&bar[XB_TOPGEN]) == tg, bar);
            __builtin_amdgcn_fence(__ATOMIC_ACQUIRE, "agent");
            xb_add(&bar[XB_XGEN(b.x)], 1u);
            asm volatile("s_waitcnt vmcnt(0)" ::: "memory");
        } else {
            XB_SPIN(xb_ld(&bar[XB_XGEN(b.x)]) == gen, bar);
            __builtin_amdgcn_fence(__ATOMIC_ACQUIRE, "agent");
            asm volatile("s_waitcnt vmcnt(0)" ::: "memory");
        }
    }
    __syncthreads();
}

#include <hip/hip_bf16.h>
#include <cmath>
namespace attn_body {
using bf16=__hip_bfloat16;
using bf16x8=__attribute__((ext_vector_type(8)))short;
using s16x4=__attribute__((ext_vector_type(4)))short;
using f32x16=__attribute__((ext_vector_type(16)))float;
using u32x4=__attribute__((ext_vector_type(4)))unsigned;
constexpr int BATCH=8,NHEAD=16,SEQ=2048,D=64,DM=NHEAD*D;
constexpr int NW=8,QBLK=32,QB=QBLK*NW,KVBLK=64,NQB=SEQ/QB;
constexpr int ATTN_PITCH=DM, ATTN_UNIT_ROWS=QB;
__device__ __forceinline__ int crow(int r,int hi){return (r&3)+8*(r>>2)+4*hi;}
#define SBAR() __builtin_amdgcn_sched_barrier(0)
__device__ __forceinline__ void cmask(f32x16&p0,f32x16&p1,int jb,int qrel,int hi){
  const float NEG=-INFINITY; int kb=64*jb+4*hi;
  #pragma unroll
  for(int r=0;r<16;++r){int kv=kb+(r&3)+8*(r>>2); if(kv>qrel)p0[r]=NEG; if(kv+32>qrel)p1[r]=NEG;}
}

constexpr int NSLOT=3, SLOTB=8192;
constexpr int LDS_K=0, LDS_V=NSLOT*SLOTB, LDS_WS=2*NSLOT*SLOTB, LDS_OST=LDS_WS+NW*64*4, LDS_BIAS=LDS_OST+NW*4096, LDS_BYTES=LDS_BIAS+SEQ*8;
constexpr float C2=0.125f*1.4426950408889634f;
__device__ __forceinline__ void glds16(const void*gsrc,unsigned lds_dst){unsigned keep;
  asm volatile("s_mov_b32 %0, m0\n\ts_mov_b32 m0, %2\n\ts_nop 0\n\tglobal_load_lds_dwordx4 %1, off\n\ts_mov_b32 m0, %0":"=&s"(keep):"v"(gsrc),"s"(lds_dst):"memory");}
__device__ __forceinline__ float max3f(float a,float b,float c){float r;asm("v_max3_f32 %0, %1, %2, %3":"=v"(r):"v"(a),"v"(b),"v"(c));return r;}
__device__ __forceinline__ float max2f(float a,float b){float r;asm("v_max_f32_e32 %0, %1, %2":"=v"(r):"v"(a),"v"(b));return r;}
__device__ __forceinline__ float fadd_s(float a,float b){float r;asm("v_add_f32_e32 %0, %1, %2":"=v"(r):"v"(a),"v"(b));return r;}
__device__ __forceinline__ float fsub_s(float a,float b){float r;asm("v_sub_f32_e32 %0, %1, %2":"=v"(r):"v"(a),"v"(b));return r;}
typedef float f32x2_t __attribute__((ext_vector_type(2))); typedef __bf16 bf16x2_t __attribute__((ext_vector_type(2)));
__device__ __forceinline__ unsigned cvtpk_s(float lo,float hi){f32x2_t v={lo,hi};bf16x2_t b=__builtin_convertvector(v,bf16x2_t);return __builtin_bit_cast(unsigned,b);}
#define WAIT_BAR(N) asm volatile("s_waitcnt vmcnt(" #N ") lgkmcnt(0)\n\ts_barrier":::"memory")

__device__ __forceinline__ void qkt(f32x16&p0,f32x16&p1,const char*Kslot,const bf16x8*qr,int r32,int hi,bf16x8 bf0,bf16x8 bf1,bf16x8 qone){
  const char*kb=Kslot+hi*1024+r32*16;
  #pragma unroll
  for(int d0=0;d0<4;++d0){
    const bf16x8 b0=*reinterpret_cast<const bf16x8*>(kb+d0*2048);
    const bf16x8 b1=*reinterpret_cast<const bf16x8*>(kb+d0*2048+512);
    if(d0==0){p0=__builtin_amdgcn_mfma_f32_32x32x16_bf16(b0,qr[0],(f32x16){},0,0,0);p1=__builtin_amdgcn_mfma_f32_32x32x16_bf16(b1,qr[0],(f32x16){},0,0,0);}
    else{p0=__builtin_amdgcn_mfma_f32_32x32x16_bf16(b0,qr[d0],p0,0,0,0);p1=__builtin_amdgcn_mfma_f32_32x32x16_bf16(b1,qr[d0],p1,0,0,0);}}
  p0=__builtin_amdgcn_mfma_f32_32x32x16_bf16(bf0,qone,p0,0,0,0);p1=__builtin_amdgcn_mfma_f32_32x32x16_bf16(bf1,qone,p1,0,0,0);
}
typedef __attribute__((address_space(3))) const char* lds_cptr;
typedef short v4i16_t __attribute__((ext_vector_type(4)));
__device__ __forceinline__ void kload8(bf16x8*kf,lds_cptr kp){
  kf[0]=*(const __attribute__((address_space(3))) bf16x8*)(kp);      kf[1]=*(const __attribute__((address_space(3))) bf16x8*)(kp+512);
  kf[2]=*(const __attribute__((address_space(3))) bf16x8*)(kp+2048); kf[3]=*(const __attribute__((address_space(3))) bf16x8*)(kp+2560);
  kf[4]=*(const __attribute__((address_space(3))) bf16x8*)(kp+4096); kf[5]=*(const __attribute__((address_space(3))) bf16x8*)(kp+4608);
  kf[6]=*(const __attribute__((address_space(3))) bf16x8*)(kp+6144); kf[7]=*(const __attribute__((address_space(3))) bf16x8*)(kp+6656);
}
__device__ __forceinline__ void kload2(bf16x8*kf,lds_cptr kp,int j){ kf[2*j]=*(const __attribute__((address_space(3))) bf16x8*)(kp+j*2048); kf[2*j+1]=*(const __attribute__((address_space(3))) bf16x8*)(kp+j*2048+512); }
__device__ __forceinline__ s16x4 vtr(lds_cptr p){ return __builtin_bit_cast(s16x4,__builtin_amdgcn_ds_read_tr16_b64_v4i16((__attribute__((address_space(3))) v4i16_t*)p)); }
__device__ __forceinline__ float rowmax(const f32x16&p0,const f32x16&p1){
  float a=max3f(p0[0],p0[1],p1[0]),b=max3f(p0[2],p0[3],p1[1]);a=max3f(a,p1[2],p1[3]);
  #pragma unroll
  for(int r=4;r<16;r+=4){a=max3f(a,p0[r],p0[r+1]);b=max3f(b,p0[r+2],p0[r+3]);a=max3f(a,p1[r],p1[r+1]);b=max3f(b,p1[r+2],p1[r+3]);}
  const float m=max2f(a,b);
  auto rr=__builtin_amdgcn_permlane32_swap(__float_as_uint(m),__float_as_uint(m),false,false);
  return max2f(__uint_as_float(rr[0]),__uint_as_float(rr[1]));
}
__device__ __forceinline__ void pv(f32x16*o,int vb,bf16x8 pa0,bf16x8 pa1,bf16x8 pa2,bf16x8 pa3){
  #pragma unroll
  for(int d0=0;d0<2;++d0){s16x4 lo[4],hi[4];
    #pragma unroll
    for(int ks=0;ks<4;++ks){
      asm volatile("ds_read_b64_tr_b16 %0,%1 offset:%c2":"=&v"(lo[ks]):"v"(vb),"i"(d0*4096+ks*1024):"memory");
      asm volatile("ds_read_b64_tr_b16 %0,%1 offset:%c2":"=&v"(hi[ks]):"v"(vb),"i"(d0*4096+ks*1024+512):"memory");}
    asm volatile("s_waitcnt lgkmcnt(0)":::"memory");SBAR();
    #define PK(k) (bf16x8){lo[k][0],lo[k][1],lo[k][2],lo[k][3],hi[k][0],hi[k][1],hi[k][2],hi[k][3]}
    o[d0]=__builtin_amdgcn_mfma_f32_32x32x16_bf16(pa0,PK(0),o[d0],0,0,0);
    o[d0]=__builtin_amdgcn_mfma_f32_32x32x16_bf16(pa1,PK(1),o[d0],0,0,0);
    o[d0]=__builtin_amdgcn_mfma_f32_32x32x16_bf16(pa2,PK(2),o[d0],0,0,0);
    o[d0]=__builtin_amdgcn_mfma_f32_32x32x16_bf16(pa3,PK(3),o[d0],0,0,0);
    #undef PK
  }
}

#ifndef ATTN_STORE16
#define ATTN_STORE16(p,v) (*(u32x4*)(p)=(v))
#endif
template<int THRL> __device__ __forceinline__ void attn_unit(int b,int h,int qb,const bf16*Q,const bf16*__restrict__ K,const bf16*__restrict__ V,bf16*O,const unsigned short*__restrict__ CB,const unsigned short*__restrict__ SBZ,char*shm,const int wid){
  const int lane=lane_now(),r32=lane&31,hi=lane>>5;
  const long rowbase=(long)b*SEQ; const int q0=qb*QB;
  const bf16*Qw=Q+(rowbase+q0+wid*QBLK)*DM+h*D;
  const bf16*Kh=K+rowbase*DM+h*D,*Vh=V+rowbase*DM+h*D;
  const unsigned lds0=(unsigned)(uintptr_t)shm;
  float*wsf=(float*)(shm+LDS_WS)+wid*64;
  const bf16*ksrc=Kh+(long)lane*DM+wid*8;
  const bf16*vsrc=Vh+(long)(16*(wid&3)+(lane>>2))*DM+(wid>>2)*32+(lane&3)*8;
  const unsigned kdst=lds0+LDS_K+wid*1024, vdst=lds0+LDS_V+wid*1024;
  #define DMA_K(t,slot) glds16(ksrc+(long)(t)*KVBLK*DM,(unsigned)__builtin_amdgcn_readfirstlane(kdst+(slot)))
  #define DMA_V(t,slot) glds16(vsrc+(long)(t)*KVBLK*DM,(unsigned)__builtin_amdgcn_readfirstlane(vdst+(slot)))
  const int vb0=(int)(lds0+LDS_V)+((lane>>4)&1)*32+(lane&3)*8+(4*hi+((lane&15)>>2))*64;
  const char*Kbase=shm+LDS_K; bf16x8 kf[8];
  const lds_cptr shm3=(lds_cptr)shm; const lds_cptr kp0=shm3+LDS_K+hi*1024+r32*16; const lds_cptr vp0=shm3+LDS_V+((lane>>4)&1)*32+(lane&3)*8+(4*hi+((lane&15)>>2))*64;
  const int NT=(q0+QB)/KVBLK;
  { const char*cbsrc=(const char*)CB+((long)(b*NHEAD+h)*SEQ)*8+lane*16;
    for(int pc=wid;pc<2*(qb+1);pc+=NW) glds16(cbsrc+pc*1024,(unsigned)__builtin_amdgcn_readfirstlane(lds0+LDS_BIAS+pc*1024)); }
  bf16x8 qone;
  #define MKQB() do{ const float nm_=-mhat; const unsigned h1_=cvtpk_s(nm_,0.f)&0xffffu; const float r1_=nm_-__uint_as_float(h1_<<16); const unsigned h2_=cvtpk_s(r1_,0.f)&0xffffu; \
      const float r2_=r1_-__uint_as_float(h2_<<16); const unsigned h3_=cvtpk_s(r2_,0.f)&0xffffu; u32x4 q_; q_[0]=0x3F803F80u; q_[1]=0x3F80u|(h1_<<16); q_[2]=h2_|(h3_<<16); q_[3]=0u; \
      if(hi!=0){q_[0]=0u;q_[1]=0u;q_[2]=0u;} qone=__builtin_bit_cast(bf16x8,q_); }while(0)
  const lds_cptr bp0=(lds_cptr)shm+LDS_BIAS+r32*8;
  #define BFRAG(t,hf) ({ const s16x4 v_=*(const __attribute__((address_space(3))) s16x4*)(bp0+((t)*64+(hf)*32)*8); (bf16x8){v_[0],v_[1],v_[2],v_[3],0x3F80,0x3F80,0,0}; })
  DMA_K(0,0);DMA_V(0,0);DMA_K(1,SLOTB);
  bf16x8 qr[4];
  #pragma unroll
  for(int d0=0;d0<4;++d0)qr[d0]=*reinterpret_cast<const bf16x8*>(&Qw[(long)r32*DM+d0*16+hi*8]);
  float mhat=0.f,l_reg=0.f;f32x16 o[2];o[0]=f32x16{};o[1]=f32x16{};
  const int qrel=wid*QBLK+r32;
  #define CMASK(P0,P1,t) do{int jb_=(t)-(NT-4); if(jb_>=0)cmask(P0,P1,jb_,qrel,hi);}while(0)
  bool resc=false;
  #define START(P0,P1) do{ const float rm=rowmax(P0,P1); resc=false; \
    { const float dl=rm; mhat=fadd_s(mhat,dl); \
      _Pragma("unroll") for(int r=0;r<16;++r){P0[r]=fsub_s(P0[r],dl);P1[r]=fsub_s(P1[r],dl);} \
      MKQB(); } \
    _Pragma("unroll") for(int r=0;r<16;++r)P0[r]=__builtin_amdgcn_exp2f(P0[r]); }while(0)
  #define RESC() do{ if(resc){ asm volatile("s_waitcnt lgkmcnt(0)":::"memory"); \
      _Pragma("unroll") for(int d_=0;d_<2;++d_) _Pragma("unroll") for(int r=0;r<16;++r)o[d_][r]*=wsf[crow(r,hi)]; } }while(0)
  f32x16 pA0,pA1,pB0,pB1;
  int sl_prev=0,sl_cur=0,sl_next=SLOTB;
  #define ROT() do{sl_prev=sl_cur;sl_cur=sl_next;sl_next=(sl_next==(NSLOT-1)*SLOTB)?0:sl_next+SLOTB;}while(0)
  DMA_K(2,2*SLOTB);
  WAIT_BAR(3);
  MKQB(); qkt(pA0,pA1,Kbase,qr,r32,hi,BFRAG(0,0),BFRAG(0,1),qone);asm volatile("s_nop 15\n\ts_nop 7":"+v"(pA0),"+v"(pA1));CMASK(pA0,pA1,0);
  START(pA0,pA1);
  _Pragma("unroll") for(int r=0;r<16;++r)pA1[r]=__builtin_amdgcn_exp2f(pA1[r]);
  WAIT_BAR(0);
  DMA_K(3,0);DMA_V(1,SLOTB);
  ROT();
  kload8(kf,kp0+sl_cur);
  WAIT_BAR(2);
  s16x4 vlo[8],vhi[8]; u32x4 pw0,pw1,pw2,pw3;
  #define PKW(P,B) cvtpk_s(P[B],P[B+1])
  #define PAF(k) __builtin_bit_cast(bf16x8,pw##k)
  #define VFR(i) (bf16x8){vlo[i][0],vlo[i][1],vlo[i][2],vlo[i][3],vhi[i][0],vhi[i][1],vhi[i][2],vhi[i][3]}
  #define PIN(x) asm volatile("":"+v"(x))
  #define MX3(a,b,c) __builtin_fmaxf(__builtin_fmaxf((a),(b)),(c))
  #define GAPA(MF,A0,A1,A2,A3,W0,W1,PW) do{ MF; sacc+=A0; sacc+=A1; sacc+=A2; sacc+=A3; PIN(sacc); W0; W1; PIN(PW); SBAR(); }while(0)
  #define EX(v) __builtin_amdgcn_exp2f(v)
  #define GAPB(MF,X,B) do{ MF; X[B]=EX(X[B]); X[B+1]=EX(X[B+1]); X[B+2]=EX(X[B+2]); X[B+3]=EX(X[B+3]); PIN(X); SBAR(); }while(0)
  #define VRD(i) do{ vlo[i]=vtr(vp_+(((i)>>2)*4096+((i)&3)*1024)); vhi[i]=vtr(vp_+(((i)>>2)*4096+((i)&3)*1024+512)); }while(0)
  #define KRD(G,j) do{ if(G){ kload2(kf,kp0+sl_next,j); SBAR(); } }while(0)
  #define STEP(C0,C1,P0,P1,t,GK,GV,GL) do{ SBAR(); \
    const lds_cptr vp_=vp0+sl_prev; const bf16x8 bfa_=BFRAG(t,0), bfb_=BFRAG(t,1); \
    VRD(0); SBAR(); float sacc=(P0[0]+P0[1]); \
    GAPA(C0=__builtin_amdgcn_mfma_f32_32x32x16_bf16(kf[0],qr[0],(f32x16){},0,0,0), P0[2],P0[3],P0[4],P0[5],     pw0[0]=PKW(P0,0), pw0[1]=PKW(P0,2), pw0); \
    VRD(4); SBAR(); GAPA(C1=__builtin_amdgcn_mfma_f32_32x32x16_bf16(kf[1],qr[0],(f32x16){},0,0,0), P0[6],P0[7],P0[8],P0[9],     pw0[2]=PKW(P0,4), pw0[3]=PKW(P0,6), pw0); \
    C0=__builtin_amdgcn_mfma_f32_32x32x16_bf16(bfa_,qone,C0,0,0,0); C1=__builtin_amdgcn_mfma_f32_32x32x16_bf16(bfb_,qone,C1,0,0,0); SBAR(); \
    VRD(1); SBAR(); GAPA(C0=__builtin_amdgcn_mfma_f32_32x32x16_bf16(kf[2],qr[1],C0,0,0,0),   P0[10],P0[11],P0[12],P0[13], pw1[0]=PKW(P0,8), pw1[1]=PKW(P0,10), pw1); \
    VRD(5); SBAR(); GAPA(C1=__builtin_amdgcn_mfma_f32_32x32x16_bf16(kf[3],qr[1],C1,0,0,0),   P0[14],P0[15],P1[0],P1[1],   pw1[2]=PKW(P0,12),pw1[3]=PKW(P0,14), pw1); \
    VRD(2); SBAR(); GAPA(C0=__builtin_amdgcn_mfma_f32_32x32x16_bf16(kf[4],qr[2],C0,0,0,0),   P1[2],P1[3],P1[4],P1[5],     pw2[0]=PKW(P1,0), pw2[1]=PKW(P1,2), pw2); \
    VRD(6); SBAR(); GAPA(C1=__builtin_amdgcn_mfma_f32_32x32x16_bf16(kf[5],qr[2],C1,0,0,0),   P1[6],P1[7],P1[8],P1[9],     pw2[2]=PKW(P1,4), pw2[3]=PKW(P1,6), pw2); \
    VRD(3); SBAR(); GAPA(C0=__builtin_amdgcn_mfma_f32_32x32x16_bf16(kf[6],qr[3],C0,0,0,0),   P1[10],P1[11],P1[12],P1[13], pw3[0]=PKW(P1,8), pw3[1]=PKW(P1,10), pw3); \
    VRD(7); SBAR(); GAPA(C1=__builtin_amdgcn_mfma_f32_32x32x16_bf16(kf[7],qr[3],C1,0,0,0),   P1[14],P1[15],0.f,0.f,       pw3[2]=PKW(P1,12),pw3[3]=PKW(P1,14), pw3); \
    l_reg+=sacc; \
    if(GK){DMA_K((t)+3,sl_cur);} if(GV){DMA_V((t)+1,sl_next);} \
    CMASK(C0,C1,t); \
    { float a=MX3(C0[0],C0[1],C1[0]),b=MX3(C0[2],C0[3],C1[1]); a=MX3(a,C1[2],C1[3]); \
      _Pragma("unroll") for(int r=4;r<16;r+=4){a=MX3(a,C0[r],C0[r+1]);b=MX3(b,C0[r+2],C0[r+3]);a=MX3(a,C1[r],C1[r+1]);b=MX3(b,C1[r+2],C1[r+3]);} \
      float rm=__builtin_fmaxf(a,b); { auto rr=__builtin_amdgcn_permlane32_swap(__float_as_uint(rm),__float_as_uint(rm),false,false); rm=__builtin_fmaxf(__uint_as_float(rr[0]),__uint_as_float(rr[1])); } \
      resc=false; \
      if(__builtin_expect(__any(rm>(float)THRL),0)){ const float dl=__builtin_fmaxf(rm,0.f); mhat+=dl; \
        _Pragma("unroll") for(int r=0;r<16;++r){C0[r]-=dl;C1[r]-=dl;} \
        MKQB(); \
        const float f=__builtin_amdgcn_exp2f(-dl); l_reg*=f; if(hi==0)wsf[r32]=f; resc=true; } } \
    SBAR(); \
    GAPB(o[0]=__builtin_amdgcn_mfma_f32_32x32x16_bf16(PAF(0),VFR(0),o[0],0,0,0), C0,0); \
    GAPB(o[1]=__builtin_amdgcn_mfma_f32_32x32x16_bf16(PAF(0),VFR(4),o[1],0,0,0), C0,4); \
    KRD(GL,0); GAPB(o[0]=__builtin_amdgcn_mfma_f32_32x32x16_bf16(PAF(1),VFR(1),o[0],0,0,0), C0,8); \
    KRD(GL,1); GAPB(o[1]=__builtin_amdgcn_mfma_f32_32x32x16_bf16(PAF(1),VFR(5),o[1],0,0,0), C0,12); \
    KRD(GL,2); GAPB(o[0]=__builtin_amdgcn_mfma_f32_32x32x16_bf16(PAF(2),VFR(2),o[0],0,0,0), C1,0); \
    KRD(GL,3); GAPB(o[1]=__builtin_amdgcn_mfma_f32_32x32x16_bf16(PAF(2),VFR(6),o[1],0,0,0), C1,4); \
    GAPB(o[0]=__builtin_amdgcn_mfma_f32_32x32x16_bf16(PAF(3),VFR(3),o[0],0,0,0), C1,8); \
    GAPB(o[1]=__builtin_amdgcn_mfma_f32_32x32x16_bf16(PAF(3),VFR(7),o[1],0,0,0), C1,12); \
    }while(0)
  int t=1;
  #undef CMASK
  #define CMASK(P0,P1,t) do{}while(0)
  for(;t+5<NT;t+=2){
    STEP(pB0,pB1,pA0,pA1,t,true,true,true);     WAIT_BAR(2); RESC(); ROT();
    STEP(pA0,pA1,pB0,pB1,t+1,true,true,true);   WAIT_BAR(2); RESC(); ROT();
  }
  #undef CMASK
  #define CMASK(P0,P1,t) do{int jb_=(t)-(NT-4); if(jb_>=0)cmask(P0,P1,jb_,qrel,hi);}while(0)
  #define ENDW(tt) do{ if((tt)+3<NT){WAIT_BAR(2);} else if((tt)+2<NT){WAIT_BAR(1);} else {WAIT_BAR(0);} }while(0)
  for(;t+1<NT;t+=2){
    STEP(pB0,pB1,pA0,pA1,t,(t+3<NT),(t+1<NT),(t+1<NT));       ENDW(t);   RESC(); ROT();
    STEP(pA0,pA1,pB0,pB1,t+1,(t+4<NT),(t+2<NT),(t+2<NT));     ENDW(t+1); RESC(); ROT();
  }
  STEP(pB0,pB1,pA0,pA1,NT-1,false,false,false); RESC();
  { float sacc=pB0[0]+pB0[1]; _Pragma("unroll") for(int r=2;r<16;++r)sacc+=pB0[r]; _Pragma("unroll") for(int r=0;r<16;++r)sacc+=pB1[r]; l_reg+=sacc;
    pw0=(u32x4){PKW(pB0,0),PKW(pB0,2),PKW(pB0,4),PKW(pB0,6)};pw1=(u32x4){PKW(pB0,8),PKW(pB0,10),PKW(pB0,12),PKW(pB0,14)};pw2=(u32x4){PKW(pB1,0),PKW(pB1,2),PKW(pB1,4),PKW(pB1,6)};pw3=(u32x4){PKW(pB1,8),PKW(pB1,10),PKW(pB1,12),PKW(pB1,14)};
    SBAR(); pv(o,vb0+sl_cur,PAF(0),PAF(1),PAF(2),PAF(3)); }
  #undef PKW
  #undef PAF
  #undef VFR
  #undef PIN
  #undef MX3
  #undef GAPA
  #undef GAPB
  #undef EX
  #undef VRD
  #undef KRD
  #undef STEP
  #undef ENDW
  {auto rr=__builtin_amdgcn_permlane32_swap(__float_as_uint(l_reg),__float_as_uint(l_reg),false,false);l_reg=__uint_as_float(rr[0])+__uint_as_float(rr[1]);}
  if(hi==0)wsf[32+r32]=l_reg;asm volatile("s_waitcnt lgkmcnt(0)":::"memory");
  float rli[16];
  #pragma unroll
  for(int r=0;r<16;++r)rli[r]=__builtin_amdgcn_rcpf(wsf[32+crow(r,hi)]);
  bf16*Ow=O+(rowbase+q0+wid*QBLK)*DM+h*D;
  { bf16*stg=(bf16*)(shm+LDS_OST)+wid*2048;
    #pragma unroll
    for(int r=0;r<16;++r){const int orow=crow(r,hi);
      #pragma unroll
      for(int d0=0;d0<2;++d0)stg[orow*64+d0*32+r32]=__float2bfloat16(o[d0][r]*rli[r]);}
    asm volatile("s_waitcnt lgkmcnt(0)":::"memory");
    const unsigned short*Gw=SBZ+(rowbase+q0+wid*QBLK)*DM+h*D;
    #pragma unroll
    for(int i=0;i<4;++i){const int row=i*8+(lane>>3),ch=lane&7; const u32x4 v=*(const u32x4*)(stg+row*64+ch*8); const u32x4 gz=*(const u32x4*)(Gw+(long)row*DM+ch*8); u32x4 w;
      #pragma unroll
      for(int e=0;e<4;++e){ const float lo=__uint_as_float(v[e]<<16)*__uint_as_float(gz[e]<<16), hi_=__uint_as_float(v[e]&0xffff0000u)*__uint_as_float(gz[e]&0xffff0000u); w[e]=cvtpk_s(lo,hi_); }
      ATTN_STORE16(Ow+(long)row*DM+ch*8,w);} }
  asm volatile("s_waitcnt lgkmcnt(0)\n\ts_barrier":::"memory");
  #undef BFRAG
  #undef MKQB
  #undef DMA_K
  #undef DMA_V
  #undef CMASK
  #undef START
  #undef RESC
  #undef ROT
}
constexpr int ATTN_LDS_BYTES=LDS_BYTES;
#undef SBAR
#undef WAIT_BAR
}
namespace ml {
using bf16x8 = __attribute__((ext_vector_type(8))) short;
using s16x4 = __attribute__((ext_vector_type(4))) short;
using f32x16 = __attribute__((ext_vector_type(16))) float;
using f32x4 = __attribute__((ext_vector_type(4))) float;
using u32x4 = __attribute__((ext_vector_type(4))) unsigned;
using u32x2 = __attribute__((ext_vector_type(2))) unsigned;
typedef short v4i16_t __attribute__((ext_vector_type(4)));
#define MLAS __attribute__((address_space(3)))
constexpr int SEQ = 2048, NCH = SEQ / 64, DMODEL = 1024;
constexpr int QC_RS = 272, KW_RS = 320, V_RS = 576, P_RS = 144, ST_RS = 80;
constexpr int L_QC = 0, L_KC = L_QC + 64 * QC_RS, L_KW = L_KC + 64 * QC_RS, L_V = L_KW + 64 * KW_RS, L_P = L_V + 64 * V_RS, L_VEC = L_P + 64 * P_RS;
constexpr int V_US = 0, V_UL = 64, V_WI = 128, V_EM = 192, V_WK = 256, V_RS2 = 320  , V_QN = 448, V_SSQ = 512  , V_NST = 1024  , V_CW = 1152  , V_WS = 2432  , V_END = 3456;
constexpr int L_STG = L_VEC + V_END * 4, STG_W = 32 * ST_RS  , L_END = L_STG + 8 * STG_W;
static_assert(L_END <= 139264, "mLSTM LDS map");
constexpr float L2E = 1.4426950408889634f;

__device__ __forceinline__ float bflo(unsigned w) { return __uint_as_float(w << 16); }
__device__ __forceinline__ float bfhi(unsigned w) { return __uint_as_float(w & 0xffff0000u); }
typedef float f32x2_t __attribute__((ext_vector_type(2))); typedef __bf16 bf16x2_t __attribute__((ext_vector_type(2)));
__device__ __forceinline__ unsigned pkbf(float lo, float hi) { f32x2_t v = {lo, hi}; bf16x2_t b = __builtin_convertvector(v, bf16x2_t); return __builtin_bit_cast(unsigned, b); }
__device__ __forceinline__ s16x4 trrd(const MLAS unsigned char* p) { return __builtin_bit_cast(s16x4, __builtin_amdgcn_ds_read_tr16_b64_v4i16((MLAS v4i16_t*)p)); }
__device__ __forceinline__ bf16x8 cat8(s16x4 a, s16x4 b) { return (bf16x8){a[0], a[1], a[2], a[3], b[0], b[1], b[2], b[3]}; }
__device__ __forceinline__ int crow(int r, int hi) { return (r & 3) + 8 * (r >> 2) + 4 * hi; }
#define ML_BAR() do { asm volatile("s_waitcnt vmcnt(0) lgkmcnt(0)" ::: "memory"); __builtin_amdgcn_s_barrier(); asm volatile("" ::: "memory"); } while (0)

__device__ __forceinline__ void mlstm_unit(const unsigned short* __restrict__ AQK, const unsigned short* __restrict__ AV, unsigned short* HA, const float* __restrict__ LI, const float* __restrict__ LFA,
                                           const float* __restrict__ conv_w, const float* __restrict__ conv_b, const float* __restrict__ hn_g, MLAS unsigned char* lds, int unit, const int wid) {
    const int b = unit >> 2, h = unit & 3;
    MLAS float* vec = (MLAS float*)(lds + L_VEC);
    const size_t row0 = (size_t)b * SEQ;
    { const int lane = lane_now(), tid = wid * 64 + lane;
    for (int i = tid; i < 5 * 256; i += 512) { const int kk = i >> 8, c = i & 255; const int ch = (c < 128) ? (h * 128 + c) : (512 + h * 128 + (c - 128)); vec[V_CW + i] = (kk < 4) ? conv_w[kk * 1024 + ch] : conv_b[ch]; }
    if (tid < 128) vec[V_NST + tid] = 0.f; }
    f32x16 C[4];
#pragma unroll
    for (int kt = 0; kt < 4; ++kt) C[kt] = (f32x16){};
    float mprev = 0.f;
    ML_BAR();
    for (int j = 0; j < NCH; ++j) {
        const int t0 = 64 * j;
        const int lane = lane_now(), tid = wid * 64 + lane, r32 = lane & 31, hi = lane >> 5;
        const int rg = tid >> 5, cc = tid & 31;
        const int gcol = (cc < 16) ? (h * 128 + 8 * cc) : (512 + h * 128 + 8 * (cc - 16));
        float lf = LFA[(row0 + t0 + lane) * 4 + h], li = LI[(row0 + t0 + lane) * 4 + h];
        float bc = lf;
#pragma unroll
        for (int o = 1; o < 64; o <<= 1) { const float y = __shfl_up(bc, o); if (lane >= o) bc += y; }
        const float g = __shfl(bc, 63);
        const float a = li - bc; float cm = a;
#pragma unroll
        for (int o = 1; o < 64; o <<= 1) { const float y = __shfl_up(cm, o); if (lane >= o) cm = fmaxf(cm, y); }
        const float mrow = bc + fmaxf(mprev, cm);
        const float cm63 = __shfl(cm, 63);
        const float mnew = fmaxf(g + mprev, g + cm63);
        const float wk = __expf(g + a - mnew), decay = __expf(g + mprev - mnew);
        if (wid == 0) { vec[V_US + lane] = a * L2E; vec[V_UL + lane] = (bc - mrow) * L2E; vec[V_WI + lane] = __expf(bc + mprev - mrow); vec[V_EM + lane] = __expf(-mrow); vec[V_WK + lane] = wk; }
        {
            {
                u32x4 vv[4];
#pragma unroll
                for (int i = 0; i < 4; ++i) { const int id = tid + 512 * i, vr = id >> 5, vc = id & 31; vv[i] = *(const u32x4*)(AV + (row0 + t0 + vr) * DMODEL + h * 256 + 8 * vc); }
#pragma unroll
                for (int i = 0; i < 4; ++i) { const int id = tid + 512 * i, vr = id >> 5, vc = id & 31; *(MLAS u32x4*)(lds + L_V + vr * V_RS + vc * 16) = vv[i]; }
            }
            u32x4 raw[7];
#pragma unroll
            for (int i = 0; i < 7; ++i) { const int t = t0 + 4 * rg - 3 + i; raw[i] = (t >= 0) ? *(const u32x4*)(AQK + (row0 + t) * DMODEL + gcol) : (u32x4){0u, 0u, 0u, 0u}; }
            float wkr[4];
#pragma unroll
            for (int i = 0; i < 4; ++i) wkr[i] = __shfl(wk, 4 * rg + i);
#pragma unroll
            for (int hc = 0; hc < 2; ++hc) {
                const MLAS f32x4* cw = (const MLAS f32x4*)(vec + V_CW + 8 * cc + 4 * hc);
                f32x4 wt[5];
#pragma unroll
                for (int kk = 0; kk < 5; ++kk) wt[kk] = cw[kk * 64];
#pragma unroll
                for (int i = 0; i < 4; ++i) {
                    const int rr = 4 * rg + i; f32x4 y = wt[4];
#pragma unroll
                    for (int kk = 0; kk < 4; ++kk) { const unsigned w0 = raw[i + kk][2 * hc], w1 = raw[i + kk][2 * hc + 1]; y[0] += wt[kk][0] * bflo(w0); y[1] += wt[kk][1] * bfhi(w0); y[2] += wt[kk][2] * bflo(w1); y[3] += wt[kk][3] * bfhi(w1); }
#pragma unroll
                    for (int e = 0; e < 4; ++e) y[e] = y[e] * __builtin_amdgcn_rcpf(1.f + __expf(-y[e]));
                    if (cc < 16) { u32x2 o; o[0] = pkbf(y[0], y[1]); o[1] = pkbf(y[2], y[3]); *(MLAS u32x2*)(lds + L_QC + rr * QC_RS + cc * 16 + hc * 8) = o; }
                    else { const float ksc = 0.08838834764831845f; y = y * ksc; u32x2 o, ow; o[0] = pkbf(y[0], y[1]); o[1] = pkbf(y[2], y[3]); y = y * wkr[i]; ow[0] = pkbf(y[0], y[1]); ow[1] = pkbf(y[2], y[3]);
                        *(MLAS u32x2*)(lds + L_KC + rr * QC_RS + (cc - 16) * 16 + hc * 8) = o; *(MLAS u32x2*)(lds + L_KW + rr * KW_RS + (cc - 16) * 16 + hc * 8) = ow; }
                }
            }
        }
        ML_BAR();
        {
            const int rb = wid >> 1, fr = lane & 15, kg = lane >> 4; float rsum[4] = {0.f, 0.f, 0.f, 0.f};
            bf16x8 qa[4];
#pragma unroll
            for (int ks = 0; ks < 4; ++ks) qa[ks] = *(const MLAS bf16x8*)(lds + L_QC + (16 * rb + fr) * QC_RS + (32 * ks + 8 * kg) * 2);
#pragma unroll
            for (int ct = 0; ct < 2; ++ct) {
                const int cbk = 2 * (wid & 1) + ct;
                f32x4 d = (f32x4){0.f, 0.f, 0.f, 0.f};
                if (cbk <= rb) {
#pragma unroll
                    for (int ks = 0; ks < 4; ++ks) { const bf16x8 kb = *(const MLAS bf16x8*)(lds + L_KC + (16 * cbk + fr) * QC_RS + (32 * ks + 8 * kg) * 2); d = __builtin_amdgcn_mfma_f32_16x16x32_bf16(qa[ks], kb, d, 0, 0, 0); }
                }
                const int s_ = 16 * cbk + fr; const float us = vec[V_US + s_];
#pragma unroll
                for (int r = 0; r < 4; ++r) { const int l_ = 16 * rb + 4 * kg + r; const float w = (s_ <= l_) ? __builtin_amdgcn_exp2f(vec[V_UL + l_] + us) : 0.f; const float p = d[r] * w;
                    const unsigned pb = pkbf(p, 0.f) & 0xffffu; *(MLAS unsigned short*)(lds + L_P + l_ * P_RS + s_ * 2) = (unsigned short)pb; rsum[r] += __uint_as_float(pb << 16); }
            }
#pragma unroll
            for (int r = 0; r < 4; ++r) { float v = rsum[r]; v += __shfl_xor(v, 1); v += __shfl_xor(v, 2); v += __shfl_xor(v, 4); v += __shfl_xor(v, 8); if (fr == 0) vec[V_RS2 + (wid & 1) * 64 + 16 * rb + 4 * kg + r] = v; }
            { const int rr = 8 * wid + (lane >> 3), sg = lane & 7; float s = 0.f;
#pragma unroll
              for (int q2 = 0; q2 < 2; ++q2) { const u32x4 qv = *(const MLAS u32x4*)(lds + L_QC + rr * QC_RS + (16 * sg + 8 * q2) * 2); const MLAS f32x4* np = (const MLAS f32x4*)(vec + V_NST + 16 * sg + 8 * q2); const f32x4 n0 = np[0], n1 = np[1];
                  s += bflo(qv[0]) * n0[0] + bfhi(qv[0]) * n0[1] + bflo(qv[1]) * n0[2] + bfhi(qv[1]) * n0[3] + bflo(qv[2]) * n1[0] + bfhi(qv[2]) * n1[1] + bflo(qv[3]) * n1[2] + bfhi(qv[3]) * n1[3]; }
              s += __shfl_xor(s, 1); s += __shfl_xor(s, 2); s += __shfl_xor(s, 4); if (sg == 0) vec[V_QN + rr] = s; }
        }
        ML_BAR();
        f32x16 num[2];
        {
            bf16x8 vf[4];
            const MLAS unsigned char* vb = lds + L_V + (8 * hi + ((lane >> 2) & 3)) * V_RS + (32 * wid + 16 * ((lane >> 4) & 1) + 4 * (lane & 3)) * 2;
#pragma unroll
            for (int ks = 0; ks < 4; ++ks) vf[ks] = cat8(trrd(vb + 16 * ks * V_RS), trrd(vb + (16 * ks + 4) * V_RS));
            MLAS float* wsf = vec + V_WS + 128 * wid;
            { const float den = vec[V_RS2 + lane] + vec[V_RS2 + 64 + lane] + vec[V_WI + lane] * vec[V_QN + lane]; const float inv = 1.f / fmaxf(fabsf(den), vec[V_EM + lane]); wsf[lane] = inv; wsf[64 + lane] = vec[V_WI + lane] * inv; }
            asm volatile("s_waitcnt lgkmcnt(0)" ::: "memory");
            u32x4 Cb[4][2];
#pragma unroll
            for (int kt = 0; kt < 4; ++kt)
#pragma unroll
                for (int s2 = 0; s2 < 2; ++s2) Cb[kt][s2] = (u32x4){pkbf(C[kt][8 * s2], C[kt][8 * s2 + 1]), pkbf(C[kt][8 * s2 + 2], C[kt][8 * s2 + 3]), pkbf(C[kt][8 * s2 + 4], C[kt][8 * s2 + 5]), pkbf(C[kt][8 * s2 + 6], C[kt][8 * s2 + 7])};
            float ysq[2];
#pragma unroll
            for (int rt = 0; rt < 2; ++rt) {
                f32x16 an = (f32x16){}, ai = (f32x16){};
#pragma unroll
                for (int ks = 0; ks < 4; ++ks) { const bf16x8 pa = *(const MLAS bf16x8*)(lds + L_P + (32 * rt + r32) * P_RS + (16 * ks + 8 * hi) * 2); an = __builtin_amdgcn_mfma_f32_32x32x16_bf16(pa, vf[ks], an, 0, 0, 0); }
#pragma unroll
                for (int kt = 0; kt < 4; ++kt)
#pragma unroll
                    for (int s = 0; s < 2; ++s) { const MLAS unsigned char* qp = lds + L_QC + (32 * rt + r32) * QC_RS + (32 * kt + 16 * s + 4 * hi) * 2;
                        const u32x2 q0 = *(const MLAS u32x2*)qp, q1 = *(const MLAS u32x2*)(qp + 16); const u32x4 qq = (u32x4){q0[0], q0[1], q1[0], q1[1]};
                        ai = __builtin_amdgcn_mfma_f32_32x32x16_bf16(__builtin_bit_cast(bf16x8, qq), __builtin_bit_cast(bf16x8, Cb[kt][s]), ai, 0, 0, 0); }
#pragma unroll
                for (int r = 0; r < 16; ++r) { const int row = 32 * rt + crow(r, hi); num[rt][r] = an[r] * wsf[row] + ai[r] * wsf[64 + row]; }
                float y[16];
#pragma unroll
                for (int i = 0; i < 16; ++i) y[i] = num[rt][i] * num[rt][i];
#pragma unroll
                for (int st = 0; st < 4; ++st) { const int d = 8 >> st; const bool up = (r32 & d) != 0;
#pragma unroll
                    for (int i = 0; i < d; ++i) { const float send = up ? y[i] : y[i + d], keep = up ? y[i + d] : y[i]; y[i] = keep + __shfl_xor(send, d); } }
                ysq[rt] = y[0] + __shfl_xor(y[0], 16);
            }
#pragma unroll
            for (int kt = 0; kt < 4; ++kt) {
#pragma unroll
                for (int r = 0; r < 16; ++r) C[kt][r] *= decay;
                const MLAS unsigned char* kb = lds + L_KW + (8 * hi + ((lane >> 2) & 3)) * KW_RS + (32 * kt + 16 * ((lane >> 4) & 1) + 4 * (lane & 3)) * 2;
#pragma unroll
                for (int ks = 0; ks < 4; ++ks) { const bf16x8 ka = cat8(trrd(kb + 16 * ks * KW_RS), trrd(kb + (16 * ks + 4) * KW_RS)); C[kt] = __builtin_amdgcn_mfma_f32_32x32x16_bf16(ka, vf[ks], C[kt], 0, 0, 0); }
            }
            { const int dk = 16 * wid + (lane & 15), sq = lane >> 4; float s = 0.f;
#pragma unroll
              for (int i = 0; i < 16; ++i) s += bflo((unsigned)*(const MLAS unsigned short*)(lds + L_KW + (16 * sq + i) * KW_RS + dk * 2));
              s += __shfl_xor(s, 16); s += __shfl_xor(s, 32); if (sq == 0) vec[V_NST + dk] = decay * vec[V_NST + dk] + s; }
            { const int rt = r32 >> 4, reg = r32 & 15; vec[V_SSQ + 64 * wid + 32 * rt + crow(reg, hi)] = rt ? ysq[1] : ysq[0]; }
        }
        mprev = mnew;
        ML_BAR();
        {
            MLAS float* wsf = vec + V_WS + 128 * wid;
            { float s = 0.f;
#pragma unroll
              for (int w8 = 0; w8 < 8; ++w8) s += vec[V_SSQ + 64 * w8 + lane];
              wsf[lane] = 1.f / sqrtf(s * (1.f / 256.f) + 1e-6f); }
            asm volatile("s_waitcnt lgkmcnt(0)" ::: "memory");
            MLAS unsigned char* stg = lds + L_STG + wid * STG_W; const float hg = hn_g[h * 256 + 32 * wid + r32];
#pragma unroll
            for (int rt = 0; rt < 2; ++rt) {
#pragma unroll
                for (int r = 0; r < 16; ++r) { const int rl = crow(r, hi); const float v = num[rt][r] * wsf[32 * rt + rl] * hg; *(MLAS unsigned short*)(stg + rl * ST_RS + r32 * 2) = (unsigned short)(pkbf(v, 0.f) & 0xffffu); }
                asm volatile("s_waitcnt lgkmcnt(0)" ::: "memory");
#pragma unroll
                for (int i = 0; i < 2; ++i) { const int id = lane + 64 * i, rl = id >> 2, c4 = id & 3; const u32x4 hv = *(const MLAS u32x4*)(stg + rl * ST_RS + c4 * 16);
                    unsigned short* gp = HA + (row0 + t0 + 32 * rt + rl) * DMODEL + h * 256 + 32 * wid + 8 * c4; const u32x4 gz = *(const u32x4*)gp; u32x4 o;
#pragma unroll
                    for (int e = 0; e < 4; ++e) o[e] = pkbf(bflo(hv[e]) * bflo(gz[e]), bfhi(hv[e]) * bfhi(gz[e]));
                    *(u32x4*)gp = o; }
                asm volatile("s_waitcnt lgkmcnt(0)" ::: "memory");
            }
        }
    }
    ML_BAR();
}
#undef MLAS
#undef ML_BAR
}
constexpr int NWAVES = 8;
constexpr int BATCH = 8, SEQ = 2048, DM = 1024, M = BATCH * SEQ, PLE = 256, NIN = 10264;
constexpr int C_AQ = 0, C_AK = 512, C_AV = 1024, C_AI = 2048, C_AF = 2052, C_AO = 2056, C_AZ = 3080, C_BQ = 4104, C_BK = 5128, C_BV = 6152, C_BF = 7176, C_BZ = 7192, C_GA = 8216, C_GB = 9240;
constexpr float EPS = 1e-6f;
constexpr size_t MiB = 1u << 20;
constexpr size_t WS_CTL = 0, CTL_ZERO_BYTES = 1 * MiB;
constexpr size_t WS_BT1 = 1 * MiB, WS_BT3 = 17 * MiB, WS_WAT = 21 * MiB, WS_WBT = 23 * MiB, WS_WOT = 25 * MiB, WS_WGT = 27 * MiB, WS_WPT = 29 * MiB;
constexpr size_t WS_LI = 29 * MiB + 512 * 1024, WS_LFA = WS_LI + 256 * 1024, WS_LFB = 30 * MiB;
constexpr size_t WS_S1 = 32 * MiB, WS_S2 = 64 * MiB, WS_S3 = 96 * MiB, WS_S4 = 128 * MiB, WS_S5 = 160 * MiB, WS_S6 = 192 * MiB, WS_S7 = 224 * MiB, WS_END = 256 * MiB;
constexpr size_t DO_SBZ = 0, DO_PB = 32 * MiB, DO_CUMB = 40 * MiB, DO_CB = 41 * MiB;
constexpr int CW_BAR = 4096;
constexpr int LDS_BYTES = 147456, LDS_CTL0 = 139264, MISC_OFF = LDS_CTL0 + 320;

typedef unsigned short bf16;
typedef unsigned v4u __attribute__((ext_vector_type(4)));
#define LDS_WAIT() asm volatile("s_waitcnt lgkmcnt(0)" ::: "memory")
__device__ __forceinline__ unsigned f2bf(float f) { unsigned u = __builtin_bit_cast(unsigned, f); return (u + 0x7fffu + ((u >> 16) & 1u)) >> 16; }
__device__ __forceinline__ unsigned pk2(float lo, float hi) { return f2bf(lo) | (f2bf(hi) << 16); }
__device__ __forceinline__ float bf2f(bf16 v) { return __uint_as_float((unsigned)v << 16); }
__device__ __forceinline__ float wave_sum(float v) {
#pragma unroll
    for (int o = 1; o < 64; o <<= 1) v += __shfl_xor(v, o);
    return v;
}

__device__ __forceinline__ int bt1_src_col(int n) {
    const int tile = n >> 8, r = n & 255;
    if (tile < 4) return C_AQ + 256 * tile + r;
    if (tile < 8) return C_AV + 256 * (tile - 4) + r;
    if (tile < 16) { const int t = tile - 8; return r < 128 ? C_AO + 128 * t + r : C_AZ + 128 * t + (r - 128); }
    if (tile < 20) return C_BQ + 256 * (tile - 16) + r;
    if (tile < 24) return C_BK + 256 * (tile - 20) + r;
    if (tile < 28) return C_BV + 256 * (tile - 24) + r;
    return C_BZ + 256 * (tile - 28) + r;
}
__device__ __forceinline__ int bt3_src_col(int n) { return n < 1024 ? C_GA + n : C_GB + (n - 1024); }

__device__ __forceinline__ void transpose_item(const float* W, int ld, int srccol0, int k0, bf16* WT, int K, int dstrow0, const float* kscale, LAS float* scr, int lane) {
#pragma unroll 8
    for (int i = 0; i < 32; ++i) { const int kk = 2 * i + (lane >> 5); float v = W[(size_t)(k0 + kk) * ld + srccol0 + (lane & 31)]; if (kscale) v *= kscale[k0 + kk]; scr[kk * 33 + (lane & 31)] = v; }
    LDS_WAIT(); asm volatile("" ::: "memory");
    const int c = lane & 7;
#pragma unroll
    for (int j = 0; j < 4; ++j) { const int n = (lane >> 3) + 8 * j; const LAS float* s = scr + (8 * c) * 33 + n;
        v4u o; o.x = pk2(s[0 * 33], s[1 * 33]); o.y = pk2(s[2 * 33], s[3 * 33]); o.z = pk2(s[4 * 33], s[5 * 33]); o.w = pk2(s[6 * 33], s[7 * 33]);
        *(GAS v4u*)(WT + (size_t)(dstrow0 + n) * K + k0 + 8 * c) = o; }
    LDS_WAIT(); asm volatile("" ::: "memory");
}

__device__ __forceinline__ float log_sigmoid_f(float z) { return fminf(z, 0.f) - log1pf(expf(-fabsf(z))); }

struct Args { const float* in[17]; float* out; unsigned char* ws; int ph_lo, ph_hi; };

__device__ __forceinline__ void p0_prologue(const Args& a, LAS unsigned char* lds, int gw, int NGW, int wave, int lane) {
    LAS float* scr = (LAS float*)(lds + wave * 16384);
    unsigned char* ws = a.ws;
    const float* w_in = a.in[3];
    constexpr int I1 = 256 * 16, I3 = 64 * 16, IW = 32 * 16, IP = 32 * 4;
    constexpr int NITEMS = I1 + I3 + 4 * IW + IP;
    for (int it = gw; it < NITEMS; it += NGW) {
        int r = it;
        if (r < I1) { const int nb = r >> 4, kb = r & 15; transpose_item(w_in, NIN, bt1_src_col(32 * nb), 64 * kb, (bf16*)(ws + WS_BT1), 1024, 32 * nb, nullptr, scr, lane); continue; } r -= I1;
        if (r < I3) { const int nb = r >> 4, kb = r & 15; transpose_item(w_in, NIN, bt3_src_col(32 * nb), 64 * kb, (bf16*)(ws + WS_BT3), 1024, 32 * nb, nullptr, scr, lane); continue; } r -= I3;
        if (r < IW) { const int nb = r >> 4, kb = r & 15; transpose_item(a.in[10], 1024, 32 * nb, 64 * kb, (bf16*)(ws + WS_WAT), 1024, 32 * nb, nullptr, scr, lane); continue; } r -= IW;
        if (r < IW) { const int nb = r >> 4, kb = r & 15; transpose_item(a.in[11], 1024, 32 * nb, 64 * kb, (bf16*)(ws + WS_WBT), 1024, 32 * nb, nullptr, scr, lane); continue; } r -= IW;
        if (r < IW) { const int nb = r >> 4, kb = r & 15; transpose_item(a.in[12], 1024, 32 * nb, 64 * kb, (bf16*)(ws + WS_WOT), 1024, 32 * nb, nullptr, scr, lane); continue; } r -= IW;
        if (r < IW) { const int nb = r >> 4, kb = r & 15; transpose_item(a.in[14], 1024, 32 * nb, 64 * kb, (bf16*)(ws + WS_WGT), 1024, 32 * nb, a.in[13], scr, lane); continue; } r -= IW;
        { const int nb = r >> 2, kb = r & 3; transpose_item(a.in[15], 1024, 32 * nb, 64 * kb, (bf16*)(ws + WS_WPT), 256, 32 * nb, nullptr, scr, lane); }
    }
    __syncthreads();
    {
        LAS float* wsm = (LAS float*)lds;
        for (int idx = wave * 64 + lane; idx < 24 * 1024; idx += NWAVES * 64) { const int c = idx >> 10, k = idx & 1023;
            const int col = c < 4 ? C_AI + c : (c < 8 ? C_AF + (c - 4) : C_BF + (c - 8)); wsm[idx] = w_in[(size_t)k * NIN + col]; }
    }
    __syncthreads();
    const float* x = a.in[0]; const float* g = a.in[2];
    f32x4 gv[4];
#pragma unroll
    for (int j = 0; j < 4; ++j) gv[j] = ((const f32x4*)g)[lane + 64 * j];
    float* LI = (float*)(ws + WS_LI); float* LFA = (float*)(ws + WS_LFA); float* LFB = (float*)(ws + WS_LFB);
    for (int m = gw; m < M; m += NGW) {
        const GAS f32x4* xr = (const GAS f32x4*)(x + (size_t)m * DM) + lane; f32x4 v[4]; float s = 0.f;
#pragma unroll
        for (int j = 0; j < 4; ++j) { v[j] = xr[64 * j]; s += (v[j].x * v[j].x + v[j].y * v[j].y) + (v[j].z * v[j].z + v[j].w * v[j].w); }
        const float rstd = 1.f / sqrtf(wave_sum(s) * (1.f / DM) + EPS);
        GAS unsigned long long* o8 = (GAS unsigned long long*)(ws + WS_S1 + (size_t)m * DM * 2) + lane;
#pragma unroll
        for (int j = 0; j < 4; ++j) { v[j] = v[j] * rstd * gv[j]; o8[64 * j] = (unsigned long long)pk2(v[j].x, v[j].y) | ((unsigned long long)pk2(v[j].z, v[j].w) << 32); }
        const LAS f32x4* wsm4 = (const LAS f32x4*)lds;
        float mine = 0.f;
#pragma unroll 1
        for (int c = 0; c < 24; ++c) {
            float d = 0.f;
#pragma unroll
            for (int j = 0; j < 4; ++j) { const f32x4 w = wsm4[c * 256 + lane + 64 * j]; d += (v[j].x * w.x + v[j].y * w.y) + (v[j].z * w.z + v[j].w * w.w); }
            d = wave_sum(d);
            if (lane == c) mine = d;
        }
        if (lane < 4) LI[(size_t)m * 4 + lane] = mine + a.in[6][lane];
        else if (lane < 8) LFA[(size_t)m * 4 + (lane - 4)] = log_sigmoid_f(mine + a.in[7][lane - 4]);
        else if (lane < 24) LFB[(size_t)m * 16 + (lane - 8)] = log_sigmoid_f(mine + a.in[9][lane - 8]);
    }
    const float* p = a.in[1];
    for (int m = gw; m < M; m += NGW) {
        const f32x4 v = ((const GAS f32x4*)(p + (size_t)m * PLE))[lane];
        ((GAS unsigned long long*)((unsigned char*)a.out + DO_PB + (size_t)m * PLE * 2))[lane] = (unsigned long long)pk2(v.x, v.y) | ((unsigned long long)pk2(v.z, v.w) << 32);
    }
}


__device__ __forceinline__ void cum_scan_unit(const float* LFB, float* CUMB, unsigned short* CB, int bh, int lane) {
    const int b = bh >> 4, h = bh & 15; float v[32]; float run = 0.f;
#pragma unroll
    for (int i = 0; i < 32; ++i) { run += LFB[((size_t)b * SEQ + 32 * lane + i) * 16 + h]; v[i] = run; }
    float incl = run;
#pragma unroll
    for (int o = 1; o < 64; o <<= 1) { const float y = __shfl_up(incl, o); if (lane >= o) incl += y; }
    const float excl = incl - run;
#pragma unroll
    for (int i = 0; i < 32; ++i) { const float cum = v[i] + excl; CUMB[(size_t)bh * SEQ + 32 * lane + i] = cum;
        const float c = -1.4426950408889634f * cum; const unsigned h1 = f2bf(c); const float r1 = c - __uint_as_float(h1 << 16); const unsigned h2 = f2bf(r1); const float r2 = r1 - __uint_as_float(h2 << 16); const unsigned h3 = f2bf(r2);
        ((unsigned long long*)CB)[(size_t)bh * SEQ + 32 * lane + i] = (unsigned long long)(h1 | (h2 << 16)) | ((unsigned long long)(h3 | (0x3F80u << 16)) << 32); }
}

__device__ __forceinline__ void mlstm_unit_naive(const bf16* AQK, const bf16* AV, bf16* GATEA_HA, const float* LI, const float* LFA, const float* conv_w, const float* conv_b, const float* hn_g,
                                                 LAS unsigned char* lds, int unit, int tid) {
    const int b = unit >> 2, h = unit & 3, v = tid & 255, half = tid >> 8;
    LAS float* qs = (LAS float*)lds; LAS float* ks = qs + 128; LAS float* nump = ks + 128; LAS float* red = nump + 256; LAS float* red2 = red + 8;
    float C[64];
#pragma unroll
    for (int d = 0; d < 64; ++d) C[d] = 0.f;
    float nreg = 0.f, mst = 0.f;
    const int ch = (v < 128) ? (h * 128 + v) : (512 + h * 128 + (v - 128));
    const float w0 = conv_w[0 * 1024 + ch], w1 = conv_w[1 * 1024 + ch], w2 = conv_w[2 * 1024 + ch], w3 = conv_w[3 * 1024 + ch], cb = conv_b[ch];
    float x0 = 0.f, x1 = 0.f, x2 = 0.f;
    const float hg = hn_g[h * 256 + v];
    for (int t = 0; t < SEQ; ++t) {
        const size_t row = (size_t)b * SEQ + t;
        if (half == 0) {
            const float x3 = bf2f(AQK[row * 1024 + ch]);
            float y = x0 * w0 + x1 * w1 + x2 * w2 + x3 * w3 + cb; x0 = x1; x1 = x2; x2 = x3;
            y = y / (1.f + expf(-y));
            if (v < 128) qs[v] = y; else ks[v - 128] = y * 0.08838834764831845f;
        }
        __syncthreads();
        const float li = LI[row * 4 + h], lf = LFA[row * 4 + h];
        const float mnew = fmaxf(lf + mst, li), fs = expf(lf + mst - mnew), is = expf(li - mnew); mst = mnew;
        const float vt = bf2f(AV[row * 1024 + h * 256 + v]);
        float num = 0.f; const float iv = is * vt;
#pragma unroll
        for (int d = 0; d < 64; ++d) { C[d] = fs * C[d] + iv * ks[64 * half + d]; num += qs[64 * half + d] * C[d]; }
        float dp = 0.f;
        if (tid < 128) { nreg = fs * nreg + is * ks[tid]; dp = nreg * qs[tid]; }
        dp = wave_sum(dp);
        if ((tid & 63) == 0) red[tid >> 6] = dp;
        if (half == 1) nump[v] = num;
        __syncthreads();
        float hval = 0.f;
        if (half == 0) { num += nump[v]; const float den = red[0] + red[1]; hval = num / fmaxf(fabsf(den), expf(-mnew)); }
        const float sq = wave_sum(hval * hval);
        if ((tid & 63) == 0) red2[tid >> 6] = sq;
        __syncthreads();
        if (half == 0) {
            const float ms = (red2[0] + red2[1] + red2[2] + red2[3]) * (1.f / 256.f);
            const size_t o = row * 1024 + h * 256 + v;
            GATEA_HA[o] = (bf16)f2bf(hval * (1.f / sqrtf(ms + EPS)) * hg * bf2f(GATEA_HA[o]));
        }
    }
    __syncthreads();
}

__device__ __forceinline__ void attn_unit_naive(bf16* BQ_HB, const bf16* BK, const bf16* BV, const bf16* SBZ, const float* CUMB, LAS unsigned char* lds, int unit, int tid) {
    const int bh = unit >> 2, qb = unit & 3, b = bh >> 4, h = bh & 15, tq = qb * 512 + tid;
    LAS float* Ks = (LAS float*)lds; LAS float* Vs = Ks + 64 * 65; LAS float* cs = Vs + 64 * 65;
    const size_t rowq = (size_t)b * SEQ + tq;
    float q[64], o[64];
#pragma unroll
    for (int d = 0; d < 64; ++d) { q[d] = bf2f(BQ_HB[rowq * 1024 + h * 64 + d]); o[d] = 0.f; }
    const float L2E = 1.4426950408889634f;
    const float cq = CUMB[(size_t)bh * SEQ + tq] * L2E;
    float mrun = -INFINITY, l = 0.f;
    const int ntile = (qb * 512 + 512) / 64;
    for (int kt = 0; kt < ntile; ++kt) {
        __syncthreads();
        for (int i = tid; i < 64 * 64; i += 512) { const int r = i >> 6, d = i & 63; const size_t rk = ((size_t)b * SEQ + kt * 64 + r) * 1024 + h * 64 + d; Ks[r * 65 + d] = bf2f(BK[rk]); Vs[r * 65 + d] = bf2f(BV[rk]); }
        if (tid < 64) cs[tid] = CUMB[(size_t)bh * SEQ + kt * 64 + tid] * L2E;
        __syncthreads();
        for (int r = 0; r < 64; ++r) {
            const int tk = kt * 64 + r; if (tk > tq) break;
            float sc = 0.f;
#pragma unroll
            for (int d = 0; d < 64; ++d) sc += q[d] * Ks[r * 65 + d];
            sc += cq - cs[r];
            if (sc > mrun) { const float f = exp2f(mrun - sc); l *= f;
#pragma unroll
                for (int d = 0; d < 64; ++d) o[d] *= f;
                mrun = sc; }
            const float pexp = exp2f(sc - mrun); l += pexp;
#pragma unroll
            for (int d = 0; d < 64; ++d) o[d] += pexp * Vs[r * 65 + d];
        }
    }
    const float inv = 1.f / l;
#pragma unroll
    for (int d = 0; d < 64; ++d) { const size_t oo = rowq * 1024 + h * 64 + d; BQ_HB[oo] = (bf16)f2bf(o[d] * inv * bf2f(SBZ[oo])); }
    __syncthreads();
}

__global__ void __launch_bounds__(NWAVES * 64, 2) fwd(Args args) {
    extern __shared__ __attribute__((aligned(16))) unsigned char lds_raw[];
    LAS unsigned char* lds = (LAS unsigned char*)lds_raw;
    const int wave = __builtin_amdgcn_readfirstlane(threadIdx.x >> 6);
    const int G = gridDim.x;
    volatile LAS unsigned* MISC = (volatile LAS unsigned*)(lds + MISC_OFF);
    for (int u = wave * 64 + lane_now(); u < (LDS_BYTES - LDS_CTL0) / 4; u += NWAVES * 64) ((LAS unsigned*)(lds + LDS_CTL0))[u] = 0u;
    __syncthreads();
    unsigned char* ws = args.ws;
    unsigned* ctl = (unsigned*)ws;
    const int lo = args.ph_lo, hi = args.ph_hi;
    XcdBarrier bar; bar.bar = ctl + CW_BAR; bar.x = 0; bar.st = nullptr;
    if (hi - lo > 1) bar = xcd_barrier_post(ctl + CW_BAR, MISC + 8, wave);
#define IN(k) (lo <= (k) && (k) < hi)
#define BOTH(k) (IN(k) && IN((k) + 1))
    using pg8::bf16_t;
    bf16_t* S1 = (bf16_t*)(ws + WS_S1); bf16_t* S2 = (bf16_t*)(ws + WS_S2); bf16_t* S3 = (bf16_t*)(ws + WS_S3); bf16_t* S4 = (bf16_t*)(ws + WS_S4);
    bf16_t* S5 = (bf16_t*)(ws + WS_S5); bf16_t* S6 = (bf16_t*)(ws + WS_S6);
    float* SSP1 = (float*)(ws + WS_S7); float* SSP2 = (float*)(ws + WS_S7 + MiB);

    if (IN(0)) { p0_prologue(args, lds, (int)blockIdx.x * NWAVES + wave, G * NWAVES, wave, lane_now()); if (BOTH(0)) xcd_barrier(bar, wave); }

    if (IN(1)) {
        if (wave == 0 && blockIdx.x < BATCH * 16) cum_scan_unit((const float*)(ws + WS_LFB), (float*)((unsigned char*)args.out + DO_CUMB), (unsigned short*)((unsigned char*)args.out + DO_CB), (int)blockIdx.x, lane_now());
        pg8::Gemm g{S1, (const bf16_t*)(ws + WS_BT1), M, 8192, 1024}; pg8::StaticOrder S; S.init(M, 8192, G, (int)blockIdx.x);
        pg8::EpiP1 E{S2, (bf16_t*)((unsigned char*)args.out + DO_SBZ)};
        pg8::gemm_phase<pg8::EpiP1, pg8::StaticOrder, PG8_ALIGN, PG8_SP2>(lds, g, S, E, wave);
        if (BOTH(1)) xcd_barrier(bar, wave);
    }
    if (IN(2)) {
        const int tid = wave * 64 + lane_now();
#ifdef MLSTM_NAIVE
        if (blockIdx.x < BATCH * 4) mlstm_unit_naive((const bf16*)S2, (const bf16*)S3, (bf16*)S4, (const float*)(ws + WS_LI), (const float*)(ws + WS_LFA), args.in[4], args.in[5], args.in[8], lds, (int)blockIdx.x, tid);
#else
        if (blockIdx.x < BATCH * 4) ml::mlstm_unit((const bf16*)S2, (const bf16*)S3, (bf16*)S4, (const float*)(ws + WS_LI), (const float*)(ws + WS_LFA), args.in[4], args.in[5], args.in[8], lds, (int)blockIdx.x, wave);
#endif
        else for (int u = (int)blockIdx.x - BATCH * 4; u < BATCH * 16 * 8; u += G - BATCH * 4) {
            const int qb = 7 - (u >> 7), bh = u & 127;
            attn_body::attn_unit<8>(bh >> 4, bh & 15, qb, (const attn_body::bf16*)S5, (const attn_body::bf16*)S6, (const attn_body::bf16*)(ws + WS_S7), (attn_body::bf16*)S5,
                                    (const unsigned short*)((unsigned char*)args.out + DO_CB), (const unsigned short*)((unsigned char*)args.out + DO_SBZ), (char*)lds_raw, wave); }
        if (BOTH(2)) xcd_barrier(bar, wave);
    }
    if (IN(3)) {
        { pg8::Gemm g{S1, (const bf16_t*)(ws + WS_BT3), M, 2048, 1024}; pg8::StaticOrder S; S.init(M, 2048, G, (int)blockIdx.x);
          pg8::EpiBf16Split<1> E{S2, S3};
          pg8::gemm_phase<pg8::EpiBf16Split<1>, pg8::StaticOrder, PG8_ALIGN, PG8_SP2>(lds, g, S, E, wave); }
        { int kpp = 256; asm volatile("" : "+s"(kpp));
          pg8::Gemm g{(const bf16_t*)((unsigned char*)args.out + DO_PB), (const bf16_t*)(ws + WS_WPT), M, 1024, kpp}; pg8::StaticOrder S; S.init(M, 1024, G, (int)blockIdx.x);
          pg8::EpiBf16Split<0> E{S6, S6};
          pg8::gemm_phase<pg8::EpiBf16Split<0>, pg8::StaticOrder, PG8_ALIGN, PG8_SP2>(lds, g, S, E, wave); }
        if (BOTH(3)) xcd_barrier(bar, wave);
    }
    if (IN(4)) {
        { pg8::Gemm g{S4, (const bf16_t*)(ws + WS_WAT), M, 1024, 1024}; pg8::StaticOrder S; S.init(M, 1024, G, (int)blockIdx.x);
          pg8::EpiGate<0> E{S2, nullptr};
          pg8::gemm_phase<pg8::EpiGate<0>, pg8::StaticOrder, false, PG8_SP2>(lds, g, S, E, wave); }
        { pg8::Gemm g{S5, (const bf16_t*)(ws + WS_WBT), M, 1024, 1024}; pg8::StaticOrder S; S.init(M, 1024, G, (int)blockIdx.x);
          pg8::EpiGate<1> E{S2, S3};
          pg8::gemm_phase<pg8::EpiGate<1>, pg8::StaticOrder, false, PG8_SP2>(lds, g, S, E, wave); }
        if (BOTH(4)) xcd_barrier(bar, wave);
    }
    if (IN(5)) {
        pg8::Gemm g{S2, (const bf16_t*)(ws + WS_WOT), M, 1024, 1024}; pg8::StaticOrder S; S.init(M, 1024, G, (int)blockIdx.x);
        pg8::EpiRes E{args.in[0], args.out, S1, SSP1};
        pg8::gemm_phase<pg8::EpiRes, pg8::StaticOrder, false, PG8_SP2>(lds, g, S, E, wave);
        if (BOTH(5)) xcd_barrier(bar, wave);
    }
    if (IN(6)) {
        pg8::Gemm g{S1, (const bf16_t*)(ws + WS_WGT), M, 1024, 1024}; pg8::StaticOrder S; S.init(M, 1024, G, (int)blockIdx.x);
        pg8::EpiPle E{args.out, S6, SSP1, SSP2, EPS};
        pg8::gemm_phase<pg8::EpiPle, pg8::StaticOrder, false, PG8_SP2>(lds, g, S, E, wave);
        if (BOTH(6)) xcd_barrier(bar, wave);
    }
    if (IN(7)) {
        const int lane = lane_now(); const float* gf = args.in[16];
        for (int m = (int)blockIdx.x * NWAVES + wave; m < M; m += G * NWAVES) {
            const f32x4* sp = (const f32x4*)(SSP2 + (size_t)m * 16); const f32x4 s0 = sp[0], s1 = sp[1], s2 = sp[2], s3 = sp[3];
            const float tot = ((s0[0] + s0[1]) + (s0[2] + s0[3])) + ((s1[0] + s1[1]) + (s1[2] + s1[3])) + ((s2[0] + s2[1]) + (s2[2] + s2[3])) + ((s3[0] + s3[1]) + (s3[2] + s3[3]));
            const float rstd = 1.f / sqrtf(tot * (1.f / DM) + EPS);
            f32x4* xr = (f32x4*)(args.out + (size_t)m * DM) + lane;
#pragma unroll
            for (int j = 0; j < 4; ++j) { const f32x4 gv = ((const f32x4*)gf)[lane + 64 * j]; xr[64 * j] = xr[64 * j] * rstd * gv; }
        }
    }
#undef IN
#undef BOTH
}


__global__ void __launch_bounds__(256) small_gates_naive(const bf16* XN, const float* w_in, const float* bias_i, const float* bias_fa, const float* bias_fb, float* LI, float* LFA, float* LFB) {
    const int lane = threadIdx.x & 63, row = blockIdx.x * 4 + (threadIdx.x >> 6);
    float xv[16];
#pragma unroll
    for (int i = 0; i < 16; ++i) xv[i] = bf2f(XN[(size_t)row * DM + lane + 64 * i]);
    for (int c = 0; c < 24; ++c) {
        const int col = c < 4 ? C_AI + c : (c < 8 ? C_AF + (c - 4) : C_BF + (c - 8));
        float s = 0.f;
#pragma unroll
        for (int i = 0; i < 16; ++i) s += xv[i] * w_in[(size_t)(lane + 64 * i) * NIN + col];
        s = wave_sum(s);
        if (lane == 0) {
            if (c < 4) LI[(size_t)row * 4 + c] = s + bias_i[c];
            else if (c < 8) LFA[(size_t)row * 4 + (c - 4)] = log_sigmoid_f(s + bias_fa[c - 4]);
            else LFB[(size_t)row * 16 + (c - 8)] = log_sigmoid_f(s + bias_fb[c - 8]);
        }
    }
}

__global__ void __launch_bounds__(256) mlstm_naive(const bf16* AQK, const bf16* AV, bf16* GATEA_HA, const float* LI, const float* LFA, const float* conv_w, const float* conv_b, const float* hn_g) {
    const int b = blockIdx.x >> 2, h = blockIdx.x & 3, v = threadIdx.x;
    __shared__ float qs[128], ks[128], red[8], red2[8];
    float C[128];
#pragma unroll
    for (int d = 0; d < 128; ++d) C[d] = 0.f;
    float nreg = 0.f, mst = 0.f;
    const int ch = (v < 128) ? (h * 128 + v) : (512 + h * 128 + (v - 128));
    const float w0 = conv_w[0 * 1024 + ch], w1 = conv_w[1 * 1024 + ch], w2 = conv_w[2 * 1024 + ch], w3 = conv_w[3 * 1024 + ch], cb = conv_b[ch];
    float x0 = 0.f, x1 = 0.f, x2 = 0.f;
    const float hg = hn_g[h * 256 + v];
    for (int t = 0; t < SEQ; ++t) {
        const size_t row = (size_t)b * SEQ + t;
        const float x3 = bf2f(AQK[row * 1024 + ch]);
        float y = x0 * w0 + x1 * w1 + x2 * w2 + x3 * w3 + cb; x0 = x1; x1 = x2; x2 = x3;
        y = y / (1.f + expf(-y));
        if (v < 128) qs[v] = y; else ks[v - 128] = y * 0.08838834764831845f;
        __syncthreads();
        const float li = LI[row * 4 + h], lf = LFA[row * 4 + h];
        const float mnew = fmaxf(lf + mst, li), fs = expf(lf + mst - mnew), is = expf(li - mnew); mst = mnew;
        const float vt = bf2f(AV[row * 1024 + h * 256 + v]);
        float num = 0.f; const float iv = is * vt;
#pragma unroll
        for (int d = 0; d < 128; ++d) { C[d] = fs * C[d] + iv * ks[d]; num += qs[d] * C[d]; }
        float dp = 0.f;
        if (v < 128) { nreg = fs * nreg + is * ks[v]; dp = nreg * qs[v]; }
        dp = wave_sum(dp);
        if ((v & 63) == 0) red[v >> 6] = dp;
        __syncthreads();
        const float den = red[0] + red[1] + red[2] + red[3];
        const float hval = num / fmaxf(fabsf(den), expf(-mnew));
        float sq = wave_sum(hval * hval);
        if ((v & 63) == 0) red2[v >> 6] = sq;
        __syncthreads();
        const float ms = (red2[0] + red2[1] + red2[2] + red2[3]) * (1.f / 256.f);
        const size_t o = row * 1024 + h * 256 + v;
        const float outv = hval * (1.f / sqrtf(ms + EPS)) * hg * bf2f(GATEA_HA[o]);
        GATEA_HA[o] = (bf16)f2bf(outv);
    }
}

__global__ void cum_naive(const float* LFB, float* CUMB) {
    const int i = blockIdx.x * blockDim.x + threadIdx.x; if (i >= BATCH * 16) return;
    const int b = i >> 4, h = i & 15; float s = 0.f;
    for (int t = 0; t < SEQ; ++t) { s += LFB[((size_t)b * SEQ + t) * 16 + h]; CUMB[(size_t)i * SEQ + t] = s; }
}

__global__ void __launch_bounds__(256) attn_naive(bf16* BQ_HB, const bf16* BK, const bf16* BV, const bf16* SBZ, const float* CUMB) {
    const int bh = blockIdx.x >> 3, qb = blockIdx.x & 7, b = bh >> 4, h = bh & 15, tq = qb * 256 + threadIdx.x;
    __shared__ float Ks[64][65], Vs[64][65], cs[64];
    const size_t rowq = (size_t)b * SEQ + tq;
    float q[64], o[64];
#pragma unroll
    for (int d = 0; d < 64; ++d) { q[d] = bf2f(BQ_HB[rowq * 1024 + h * 64 + d]); o[d] = 0.f; }
    const float L2E = 1.4426950408889634f;
    const float cq = CUMB[(size_t)bh * SEQ + tq] * L2E;
    float mrun = -INFINITY, l = 0.f;
    const int ntile = (qb * 256 + 256) / 64;
    for (int kt = 0; kt < ntile; ++kt) {
        __syncthreads();
        for (int i = threadIdx.x; i < 64 * 64; i += 256) { const int r = i >> 6, d = i & 63; const size_t rk = ((size_t)b * SEQ + kt * 64 + r) * 1024 + h * 64 + d; Ks[r][d] = bf2f(BK[rk]); Vs[r][d] = bf2f(BV[rk]); }
        if (threadIdx.x < 64) cs[threadIdx.x] = CUMB[(size_t)bh * SEQ + kt * 64 + threadIdx.x] * L2E;
        __syncthreads();
        for (int r = 0; r < 64; ++r) {
            const int tk = kt * 64 + r; if (tk > tq) break;
            float s = 0.f;
#pragma unroll
            for (int d = 0; d < 64; ++d) s += q[d] * Ks[r][d];
            s += cq - cs[r];
            if (s > mrun) { const float f = exp2f(mrun - s); l *= f;
#pragma unroll
                for (int d = 0; d < 64; ++d) o[d] *= f;
                mrun = s; }
            const float pexp = exp2f(s - mrun); l += pexp;
#pragma unroll
            for (int d = 0; d < 64; ++d) o[d] += pexp * Vs[r][d];
        }
    }
    const float inv = 1.f / l;
#pragma unroll
    for (int d = 0; d < 64; ++d) { const size_t oo = rowq * 1024 + h * 64 + d; BQ_HB[oo] = (bf16)f2bf(o[d] * inv * bf2f(SBZ[oo])); }
}

__global__ void __launch_bounds__(256) final_naive(float* X, const float* SSP2, const float* g) {
    const int lane = threadIdx.x & 63, row = blockIdx.x * 4 + (threadIdx.x >> 6);
    float tot = 0.f;
    for (int i = 0; i < 16; ++i) tot += SSP2[(size_t)row * 16 + i];
    const float rstd = 1.f / sqrtf(tot * (1.f / DM) + EPS);
    f32x4* xr = (f32x4*)(X + (size_t)row * DM) + lane;
#pragma unroll
    for (int j = 0; j < 4; ++j) { const f32x4 gv = ((const f32x4*)g)[lane + 64 * j]; xr[64 * j] = xr[64 * j] * rstd * gv; }
}


#ifdef DBG
__device__ __forceinline__ unsigned hash_u(unsigned x) { x ^= x >> 16; x *= 0x7feb352du; x ^= x >> 15; x *= 0x846ca68bu; x ^= x >> 16; return x; }
__device__ __forceinline__ float rbf(float f) { return __uint_as_float(f2bf(f) << 16); }
__device__ __forceinline__ float dot_bf(const bf16* a, const float* W, int ld, int col, int K, const float* ks) {
    float s = 0.f; for (int k = 0; k < K; ++k) { float w = W[(size_t)k * ld + col]; if (ks) w *= ks[k]; s += bf2f(a[k]) * rbf(w); } return s; }
__device__ __forceinline__ void report(float* slot, float stored, float expect) { const float d = fabsf(stored - expect) / (fabsf(expect) + 0.05f); atomicMax((unsigned*)slot, __float_as_uint(d)); }
__device__ __forceinline__ float sgm(float x) { return 1.f / (1.f + expf(-x)); }
__global__ void chk_p1(const bf16* XN, const float* w_in, const unsigned char* ws, const unsigned char* dob, float* slot) {
    const unsigned s = blockIdx.x * blockDim.x + threadIdx.x; const unsigned hsh = hash_u(s * 2654435761u + 12345u);
    const int arr = s % 7, row = hsh % M, col = (hsh >> 14) % 1024; const bf16* a = XN + (size_t)row * DM;
    float e; const bf16* st;
    switch (arr) {
    case 0: e = dot_bf(a, w_in, NIN, C_AQ + col, 1024, nullptr); st = (const bf16*)(ws + WS_S2); break;
    case 1: e = dot_bf(a, w_in, NIN, C_AV + col, 1024, nullptr); st = (const bf16*)(ws + WS_S3); break;
    case 2: { const float o = dot_bf(a, w_in, NIN, C_AO + col, 1024, nullptr), z = dot_bf(a, w_in, NIN, C_AZ + col, 1024, nullptr); e = sgm(o) * z * sgm(z); st = (const bf16*)(ws + WS_S4); } break;
    case 3: e = dot_bf(a, w_in, NIN, C_BQ + col, 1024, nullptr) * pg8::QSCALE; st = (const bf16*)(ws + WS_S5); break;
    case 4: e = dot_bf(a, w_in, NIN, C_BK + col, 1024, nullptr); st = (const bf16*)(ws + WS_S6); break;
    case 5: e = dot_bf(a, w_in, NIN, C_BV + col, 1024, nullptr); st = (const bf16*)(ws + WS_S7); break;
    default: { const float z = dot_bf(a, w_in, NIN, C_BZ + col, 1024, nullptr); e = z * sgm(z); st = (const bf16*)(dob + DO_SBZ); } break;
    }
    report(slot, bf2f(st[(size_t)row * 1024 + col]), e);
}
__global__ void chk_p3(const bf16* XN, const float* w_in, const bf16* Pb, const float* w_pp, const unsigned char* ws, float* slot) {
    const unsigned s = blockIdx.x * blockDim.x + threadIdx.x; const unsigned hsh = hash_u(s * 2654435761u + 777u);
    const int arr = s % 3, row = hsh % M, col = (hsh >> 14) % 1024; float e; const bf16* st;
    if (arr == 0) { e = sgm(dot_bf(XN + (size_t)row * DM, w_in, NIN, C_GA + col, 1024, nullptr)); st = (const bf16*)(ws + WS_S2); }
    else if (arr == 1) { e = sgm(dot_bf(XN + (size_t)row * DM, w_in, NIN, C_GB + col, 1024, nullptr)); st = (const bf16*)(ws + WS_S3); }
    else { e = dot_bf(Pb + (size_t)row * PLE, w_pp, 1024, col, 256, nullptr); st = (const bf16*)(ws + WS_S6); }
    report(slot + (arr == 0 ? 0 : (arr == 1 ? 5 : 6)), bf2f(st[(size_t)row * 1024 + col]), e);
}
__global__ void chk_p4(const unsigned char* ws, const float* w_in, const float* w_a, const float* w_b, float* slot) {
    const unsigned s = blockIdx.x * blockDim.x + threadIdx.x; const unsigned hsh = hash_u(s * 2654435761u + 999u);
    const int row = hsh % M, col = (hsh >> 14) % 1024; const bf16* XN = (const bf16*)(ws + WS_S1) + (size_t)row * DM;
    const float ga = rbf(sgm(dot_bf(XN, w_in, NIN, C_GA + col, 1024, nullptr))), gb = rbf(sgm(dot_bf(XN, w_in, NIN, C_GB + col, 1024, nullptr)));
    const float ya = dot_bf((const bf16*)(ws + WS_S4) + (size_t)row * DM, w_a, 1024, col, 1024, nullptr), yb = dot_bf((const bf16*)(ws + WS_S5) + (size_t)row * DM, w_b, 1024, col, 1024, nullptr);
    report(slot, bf2f(((const bf16*)(ws + WS_S2))[(size_t)row * 1024 + col]), rbf(ga * ya) + gb * yb);
}
__global__ void chk_p5(const unsigned char* ws, const float* x, const float* w_out, const float* X1, float* slot) {
    const unsigned s = blockIdx.x * blockDim.x + threadIdx.x; const unsigned hsh = hash_u(s * 2654435761u + 4242u);
    const int row = hsh % M, col = (hsh >> 14) % 1024;
    const float e = x[(size_t)row * DM + col] + dot_bf((const bf16*)(ws + WS_S2) + (size_t)row * DM, w_out, 1024, col, 1024, nullptr);
    report(slot, X1[(size_t)row * DM + col], e);
    report(slot, bf2f(((const bf16*)(ws + WS_S1))[(size_t)row * DM + col]), e);
    if ((s & 63) == 0) { float ss = 0.f, sp = 0.f; for (int k = 0; k < DM; ++k) { const float v = X1[(size_t)row * DM + k]; ss += v * v; } for (int k = 0; k < 16; ++k) sp += ((const float*)(ws + WS_S7))[(size_t)row * 16 + k];
        report(slot, sp, ss); }
}
__global__ void chk_p6(const unsigned char* ws, const float* w_pg, const float* gple, const float* X2, float* slot) {
    const unsigned s = blockIdx.x * blockDim.x + threadIdx.x; const unsigned hsh = hash_u(s * 2654435761u + 31337u);
    const int row = hsh % M, col = (hsh >> 14) % 1024; const bf16* xb = (const bf16*)(ws + WS_S1) + (size_t)row * DM;
    float ss = 0.f; for (int k = 0; k < DM; ++k) { const float v = bf2f(xb[k]); ss += v * v; }
    const float rstd = 1.f / sqrtf(ss / DM + EPS);
    const float z = rstd * dot_bf(xb, w_pg, 1024, col, 1024, gple);
    const float e = bf2f(xb[col]) + sgm(z) * bf2f(((const bf16*)(ws + WS_S6))[(size_t)row * DM + col]);
    report(slot, X2[(size_t)row * DM + col], e);
    if ((s & 63) == 0) { float s2 = 0.f, sp = 0.f; for (int k = 0; k < DM; ++k) { const float v = X2[(size_t)row * DM + k]; s2 += v * v; } for (int k = 0; k < 16; ++k) sp += ((const float*)(ws + WS_S7 + MiB))[(size_t)row * 16 + k];
        report(slot, sp, s2); }
}

__global__ void chk_bt3(const bf16* Bt3, const float* w_in, const bf16* GA, const bf16* XN, float* slot) {
    const unsigned s = blockIdx.x * blockDim.x + threadIdx.x; const unsigned hsh = hash_u(s * 2654435761u + 555u);
    unsigned* cnt = (unsigned*)slot;
    { const int row = (hsh % M) | 128, col = (hsh >> 14) % 1024; const float e = sgm(dot_bf(XN + (size_t)row * DM, w_in, NIN, C_GA + col, 1024, nullptr)); const float st = bf2f(GA[(size_t)row * 1024 + col]);
      const float d = fabsf(st - e) / (fabsf(e) + 0.05f);
      atomicAdd(cnt + 0, 1u);
      if (d > 0.03f) { atomicAdd(cnt + 1, 1u); const float e2 = dot_bf(XN + (size_t)row * DM, w_in, NIN, C_AQ + col, 1024, nullptr); if (fabsf(st - e2) / (fabsf(e2) + 0.05f) < 0.03f) atomicAdd(cnt + 2, 1u); } }
}
__global__ void dbg_fill(float* out, const float* slots) {
    float code = 0.f;
    { const int order[6] = {1, 3, 8, 9, 4, 5}; int mask = 0; for (int k = 0; k < 6; ++k) if (slots[order[k]] > 0.03f) mask |= 1 << k; if (slots[6] > 0.03f) mask |= 64; code = 100.f * mask; }
#if DBG >= 10
    code = slots[DBG - 10] * 1e4f;
#endif
    const size_t i = (size_t)blockIdx.x * blockDim.x + threadIdx.x; out[i] = code;
}
#endif
extern "C" void kernel_launch(void* const* d_in, const int* in_sizes, int n_in, void* d_out, int out_size, void* d_ws, size_t ws_size, hipStream_t stream) {
    static int grid = 0;
    if (grid == 0) {
        int dev = 0, cus = 0;
        if (n_in != 17 || out_size != M * DM || ws_size < WS_END) { fprintf(stderr, "kernel_launch: unexpected shapes (n_in %d out %d ws %zu)\n", n_in, out_size, ws_size); grid = -1; return; }
        if (hipGetDevice(&dev) != hipSuccess || hipDeviceGetAttribute(&cus, hipDeviceAttributeMultiprocessorCount, dev) != hipSuccess) { grid = -1; return; }
        if (hipFuncSetAttribute((const void*)fwd, hipFuncAttributeMaxDynamicSharedMemorySize, LDS_BYTES) != hipSuccess) { grid = -1; return; }
        grid = cus;
    }
    if (grid < 0) return;
    (void)hipMemsetAsync((char*)d_ws + WS_CTL, 0, CTL_ZERO_BYTES, stream);
    Args a{};
    for (int i = 0; i < 17; ++i) a.in[i] = (const float*)d_in[i];
    a.out = (float*)d_out; a.ws = (unsigned char*)d_ws;
    unsigned char* ws = (unsigned char*)d_ws; unsigned char* dob = (unsigned char*)d_out;
    a.ph_lo = 0; a.ph_hi = 8;
    hipLaunchKernelGGL(fwd, dim3(grid), dim3(NWAVES * 64), LDS_BYTES, stream, a);
}
```

```cpp
#include <hip/hip_runtime.h>
#include <cstdio>
#include <cstdint>
#include <cmath>
__device__ __forceinline__ int lane_now() { int l; asm volatile("s_nop 1\n\tv_mbcnt_lo_u32_b32 %0, -1, 0\n\tv_mbcnt_hi_u32_b32 %0, -1, %0" : "=v"(l)); return l; }
namespace pg8 {
#define PG8_LAS __attribute__((address_space(3)))
typedef unsigned short bf16_t;
typedef short bf16x8 __attribute__((ext_vector_type(8)));
typedef float f32x4 __attribute__((ext_vector_type(4)));
typedef unsigned u32x4 __attribute__((ext_vector_type(4)));
constexpr int BM = 256, BK = 64, HALF = 128, HTB = HALF * BK * 2  , STAGE_BYTES = 8 * HTB, NXCD = 8, WGM = 8;

__host__ __device__ __forceinline__ int lds_byte(int r, int c) { const int st = (r >> 4) * 2 + (c >> 5), rr = r & 15, cc = c & 31, ob = rr * 64 + cc * 2; return st * 1024 + (ob ^ (((ob >> 9) & 1) << 5)); }
__host__ __device__ __forceinline__ void stage_rc(int b, int& R, int& C) { const int st = b / 1024, sb = b % 1024, swz = sb ^ (((sb >> 9) & 1) << 5); R = (st >> 1) * 16 + swz / 64; C = (st & 1) * 32 + (swz % 64) / 2; }
__host__ __device__ __forceinline__ int perm32(int rho) { const int n = rho >> 4, i = rho & 15; return 8 * (i >> 2) + 4 * n + (i & 3); }

struct Unit { int pm, pn; };
struct Gemm { const bf16_t* A; const bf16_t* Bt; int M, N, K; };

struct StaticOrder {
    int nM, nN, nwg, G, c;
    __host__ __device__ void init(int M, int N, int G_, int c_) { nM = M / BM; nN = N / BM; nwg = nM * nN; G = G_; c = c_; }
    __host__ __device__ bool next(int i, Unit& u) const {
        const long L = (long)i * G + c; if (L >= nwg) return false;
        int wgid = (int)L; { const int q = nwg / NXCD, r = nwg % NXCD, xcd = wgid % NXCD, off = wgid / NXCD; wgid = (xcd < r ? xcd * (q + 1) : r * (q + 1) + (xcd - r) * q) + off; }
        const int nig = WGM * nN, gid = wgid / nig, fm = gid * WGM, gsz = (nM - fm) < WGM ? (nM - fm) : WGM;
        u.pm = fm + ((wgid % nig) % gsz); u.pn = (wgid % nig) / gsz; return true;
    }
    __device__ __forceinline__ void a_ready(const Unit&) const {}
    __device__ __forceinline__ void done(const Unit&) const {}
};
struct StaticOrderLim : StaticOrder {
    int imax;
    __host__ __device__ bool next(int i, Unit& u) const { if (i >= imax) return false; return StaticOrder::next(i, u); }
};
struct SubsetOrder {
    int x, r, nsub, pn0;
    __host__ __device__ bool next(int i, Unit& u) const { const int j = r + nsub * i; if (j >= 128) return false; u.pn = pn0 + (j >> 3); u.pm = 8 * x + (j & 7); return true; }
    __device__ __forceinline__ void a_ready(const Unit&) const {}
    __device__ __forceinline__ void done(const Unit&) const {}
};


typedef unsigned u32x2 __attribute__((ext_vector_type(2)));
typedef float f32x2_t __attribute__((ext_vector_type(2))); typedef __bf16 bf16x2_t __attribute__((ext_vector_type(2)));
__device__ __forceinline__ unsigned cvt_pk_bf16(float lo, float hi) { f32x2_t v = {lo, hi}; bf16x2_t b = __builtin_convertvector(v, bf16x2_t); return __builtin_bit_cast(unsigned, b); }
__device__ __forceinline__ float bf_lo(unsigned w) { return __uint_as_float(w << 16); }
__device__ __forceinline__ float bf_hi(unsigned w) { return __uint_as_float(w & 0xffff0000u); }
__device__ __forceinline__ float sigmoidf_(float x) { return __builtin_amdgcn_rcpf(1.f + __expf(-x)); }
__device__ __forceinline__ float siluf_(float x) { return x * sigmoidf_(x); }
__device__ __forceinline__ u32x4 pack8(const f32x4 a, const f32x4 b) { u32x4 w; w.x = cvt_pk_bf16(a[0], a[1]); w.y = cvt_pk_bf16(a[2], a[3]); w.z = cvt_pk_bf16(b[0], b[1]); w.w = cvt_pk_bf16(b[2], b[3]); return w; }
__device__ __forceinline__ void unpack8(const u32x4 w, f32x4& a, f32x4& b) { a = (f32x4){bf_lo(w.x), bf_hi(w.x), bf_lo(w.y), bf_hi(w.y)}; b = (f32x4){bf_lo(w.z), bf_hi(w.z), bf_lo(w.w), bf_hi(w.w)}; }

constexpr float QSCALE = 0.125f * 1.4426950408889634f;

struct EpiP1 {
    static constexpr bool PERM = true, AFTER_DRAIN = false;
    bf16_t* s2;
    bf16_t* sbz;
    __device__ __forceinline__ void operator()(const f32x4 (&acc)[2][2][4][2], const Unit& u, int wr, int wc, int fr, int fq) const {
        const int grp = u.pn >> 2;
        const int row0 = u.pm * BM + wr * 64 + fr;
        constexpr size_t SLOT = (size_t)16384 * 1024;
        if (grp == 2 || grp == 3) {
            bf16_t* base = s2 + 2 * SLOT; const int col0 = 128 * (u.pn - 8) + wc * 32 + 8 * fq;
#pragma unroll
            for (int ai = 0; ai < 2; ++ai)
#pragma unroll
                for (int m = 0; m < 4; ++m) { bf16_t* rowp = base + (size_t)(row0 + ai * HALF + m * 16) * 1024 + col0;
                    f32x4 r0, r1;
#pragma unroll
                    for (int e = 0; e < 4; ++e) { r0[e] = sigmoidf_(acc[ai][0][m][0][e]) * siluf_(acc[ai][1][m][0][e]); r1[e] = sigmoidf_(acc[ai][0][m][1][e]) * siluf_(acc[ai][1][m][1][e]); }
                    *(u32x4*)rowp = pack8(r0, r1); }
        } else {
            const int sidx = grp < 2 ? grp : grp - 1;
            bf16_t* base = (grp == 7) ? sbz : s2 + (size_t)sidx * SLOT;
            const int col0 = (u.pn & 3) * BM + wc * 32 + 8 * fq;
            const float sc = (grp == 4) ? QSCALE : 1.f;
#pragma unroll
            for (int ai = 0; ai < 2; ++ai)
#pragma unroll
                for (int m = 0; m < 4; ++m) { bf16_t* rowp = base + (size_t)(row0 + ai * HALF + m * 16) * 1024 + col0;
#pragma unroll
                    for (int bj = 0; bj < 2; ++bj) { f32x4 v0 = acc[ai][bj][m][0] * sc, v1 = acc[ai][bj][m][1] * sc;
                        if (grp == 7) {
#pragma unroll
                            for (int e = 0; e < 4; ++e) { v0[e] = siluf_(v0[e]); v1[e] = siluf_(v1[e]); } }
                        *(u32x4*)(rowp + bj * HALF) = pack8(v0, v1); } }
        }
    }
};

template <int ACT  > struct EpiBf16Split {
    static constexpr bool PERM = true, AFTER_DRAIN = false;
    bf16_t* O0; bf16_t* O1;
    __device__ __forceinline__ void operator()(const f32x4 (&acc)[2][2][4][2], const Unit& u, int wr, int wc, int fr, int fq) const {
        const int row0 = u.pm * BM + wr * 64 + fr; bf16_t* base = (u.pn < 4) ? O0 : O1;
        const int col0 = (u.pn & 3) * BM + wc * 32 + 8 * fq;
#pragma unroll
        for (int ai = 0; ai < 2; ++ai)
#pragma unroll
            for (int m = 0; m < 4; ++m) { bf16_t* rowp = base + (size_t)(row0 + ai * HALF + m * 16) * 1024 + col0;
#pragma unroll
                for (int bj = 0; bj < 2; ++bj) { f32x4 v0 = acc[ai][bj][m][0], v1 = acc[ai][bj][m][1];
                    if (ACT == 1) {
#pragma unroll
                        for (int e = 0; e < 4; ++e) { v0[e] = sigmoidf_(v0[e]); v1[e] = sigmoidf_(v1[e]); } }
                    *(u32x4*)(rowp + bj * HALF) = pack8(v0, v1); } }
    }
};

template <int SECOND> struct EpiGate {
    static constexpr bool PERM = true, AFTER_DRAIN = false;
    bf16_t* T; const bf16_t* G2;
    __device__ __forceinline__ void operator()(const f32x4 (&acc)[2][2][4][2], const Unit& u, int wr, int wc, int fr, int fq) const {
        const int row0 = u.pm * BM + wr * 64 + fr; const int col0 = u.pn * BM + wc * 32 + 8 * fq;
#pragma unroll
        for (int ai = 0; ai < 2; ++ai)
#pragma unroll
            for (int m = 0; m < 4; ++m) { const size_t off = (size_t)(row0 + ai * HALF + m * 16) * 1024 + col0;
#pragma unroll
                for (int bj = 0; bj < 2; ++bj) {
                    f32x4 t0, t1; unpack8(*(const u32x4*)(T + off + bj * HALF), t0, t1);
                    f32x4 r0, r1;
                    if (SECOND) { f32x4 g0, g1; unpack8(*(const u32x4*)(G2 + off + bj * HALF), g0, g1); r0 = g0 * acc[ai][bj][m][0] + t0; r1 = g1 * acc[ai][bj][m][1] + t1; }
                    else { r0 = t0 * acc[ai][bj][m][0]; r1 = t1 * acc[ai][bj][m][1]; }
                    *(u32x4*)(T + off + bj * HALF) = pack8(r0, r1); } }
    }
};

struct EpiRes {
    static constexpr bool PERM = false, AFTER_DRAIN = false;
    const float* x; float* X1; bf16_t* XB1; float* SSP;
    __device__ __forceinline__ void operator()(const f32x4 (&acc)[2][2][4][2], const Unit& u, int wr, int wc, int fr, int fq) const {
        const int row0 = u.pm * BM + wr * 64 + fr, col0 = u.pn * BM + wc * 32 + 4 * fq;
#pragma unroll
        for (int ai = 0; ai < 2; ++ai)
#pragma unroll
            for (int m = 0; m < 4; ++m) { const int row = row0 + ai * HALF + m * 16; const size_t off = (size_t)row * 1024 + col0; float ss = 0.f;
#pragma unroll
                for (int bj = 0; bj < 2; ++bj)
#pragma unroll
                    for (int n = 0; n < 2; ++n) { const f32x4 xv = *(const f32x4*)(x + off + bj * HALF + n * 16); const f32x4 v = xv + acc[ai][bj][m][n];
                        *(f32x4*)(X1 + off + bj * HALF + n * 16) = v; ss += (v[0] * v[0] + v[1] * v[1]) + (v[2] * v[2] + v[3] * v[3]);
                        u32x2 w; w.x = cvt_pk_bf16(v[0], v[1]); w.y = cvt_pk_bf16(v[2], v[3]); *(u32x2*)(XB1 + off + bj * HALF + n * 16) = w; }
                ss += __shfl_xor(ss, 16); ss += __shfl_xor(ss, 32);
                if (fq == 0) SSP[(size_t)row * 16 + u.pn * 4 + wc] = ss; }
    }
};

struct EpiPle {
    static constexpr bool PERM = false, AFTER_DRAIN = false;
    float* X; const bf16_t* PP; const float* SSP1; float* SSP2; float eps;
    __device__ __forceinline__ void operator()(const f32x4 (&acc)[2][2][4][2], const Unit& u, int wr, int wc, int fr, int fq) const {
        const int row0 = u.pm * BM + wr * 64 + fr, col0 = u.pn * BM + wc * 32 + 4 * fq;
#pragma unroll
        for (int ai = 0; ai < 2; ++ai)
#pragma unroll
            for (int m = 0; m < 4; ++m) { const int row = row0 + ai * HALF + m * 16; const size_t off = (size_t)row * 1024 + col0;
                const f32x4* sp = (const f32x4*)(SSP1 + (size_t)row * 16); const f32x4 s0 = sp[0], s1 = sp[1], s2 = sp[2], s3 = sp[3];
                const float tot = ((s0[0] + s0[1]) + (s0[2] + s0[3])) + ((s1[0] + s1[1]) + (s1[2] + s1[3])) + ((s2[0] + s2[1]) + (s2[2] + s2[3])) + ((s3[0] + s3[1]) + (s3[2] + s3[3]));
                const float rstd = 1.0f / sqrtf(tot * (1.0f / 1024.0f) + eps); float ss = 0.f;
#pragma unroll
                for (int bj = 0; bj < 2; ++bj)
#pragma unroll
                    for (int n = 0; n < 2; ++n) { const f32x4 xv = *(const f32x4*)(X + off + bj * HALF + n * 16); const u32x2 pw = *(const u32x2*)(PP + off + bj * HALF + n * 16);
                        const f32x4 pp = (f32x4){bf_lo(pw.x), bf_hi(pw.x), bf_lo(pw.y), bf_hi(pw.y)}; f32x4 v;
#pragma unroll
                        for (int e = 0; e < 4; ++e) v[e] = xv[e] + sigmoidf_(rstd * acc[ai][bj][m][n][e]) * pp[e];
                        *(f32x4*)(X + off + bj * HALF + n * 16) = v; ss += (v[0] * v[0] + v[1] * v[1]) + (v[2] * v[2] + v[3] * v[3]); }
                ss += __shfl_xor(ss, 16); ss += __shfl_xor(ss, 32);
                if (fq == 0) SSP2[(size_t)row * 16 + u.pn * 4 + wc] = ss; }
    }
};

template <class Epi, class Sched, bool ALIGN_EPI = false, bool SP2 = false>
__device__ __forceinline__ void gemm_phase(PG8_LAS unsigned char* lds, const Gemm g, const Sched& S, const Epi& E, const int wave_id) {
    const int wid = wave_id, lane = lane_now(), tid = wid * 64 + lane, wr = wid >> 2, wc = wid & 3, fr = lane & 15, fq = lane >> 4;
    const int K = g.K, nt = K / BK;
    unsigned voffA[2], voffB[2];
#pragma unroll
    for (int i = 0; i < 2; ++i) { int R, C; stage_rc(tid * 16 + i * 8192, R, C); const int Rb = Epi::PERM ? ((R & ~31) + perm32(R & 31)) : R;
        voffA[i] = (unsigned)(R * K + C) * 2u; voffB[i] = (unsigned)(Rb * K + C) * 2u; }
    const size_t kstep = (size_t)(BK * 2);
    const size_t hstep = (size_t)HALF * K * 2;
    const size_t tstep = 2 * hstep;
    const unsigned ldsw = (unsigned)wid * 1024u;
    const int aoff = lds_byte(wr * 64 + fr, fq * 8), boff = lds_byte(wc * 32 + fr, fq * 8);
#define PG8_SA(b, h) (((b) * 2 + (h)) * HTB)
#define PG8_SB(b, h) ((4 + (b) * 2 + (h)) * HTB)
#define PG8_STAGE(bufoff, gbase, voff) do { _Pragma("unroll") for (int _i = 0; _i < 2; ++_i) \
        __builtin_amdgcn_global_load_lds((const unsigned*)((const char*)(gbase) + (voff)[_i]), (PG8_LAS unsigned*)(lds + (bufoff) + ldsw + _i * 8192), 16, 0, 0); } while (0)
#define PG8_LDA(dst, b, h) do { _Pragma("unroll") for (int m = 0; m < 4; ++m) _Pragma("unroll") for (int k = 0; k < 2; ++k) dst[m][k] = *(const PG8_LAS bf16x8*)(lds + PG8_SA(b, h) + aoff + m * 2048 + k * 1024); } while (0)
#define PG8_LDB(dst, b, h) do { _Pragma("unroll") for (int n = 0; n < 2; ++n) _Pragma("unroll") for (int k = 0; k < 2; ++k) dst[n][k] = *(const PG8_LAS bf16x8*)(lds + PG8_SB(b, h) + boff + n * 2048 + k * 1024); } while (0)
#define PG8_MMA(ai, bj, At, Bt) do { __builtin_amdgcn_s_setprio(1); _Pragma("unroll") for (int m = 0; m < 4; ++m) _Pragma("unroll") for (int n = 0; n < 2; ++n) _Pragma("unroll") for (int k = 0; k < 2; ++k) \
        acc[ai][bj][m][n] = __builtin_amdgcn_mfma_f32_16x16x32_bf16(Bt[n][k], At[m][k], acc[ai][bj][m][n], 0, 0, 0); __builtin_amdgcn_s_setprio(0); } while (0)
#define PG8_WAIT_V(n) asm volatile("s_waitcnt vmcnt(" #n ")" ::: "memory")
#define PG8_WAIT_L(n) asm volatile("s_waitcnt lgkmcnt(" #n ")" ::: "memory")
#define PG8_BAR __builtin_amdgcn_s_barrier()
#define PG8_SCHED __builtin_amdgcn_sched_barrier(0)
    Unit cur, nxt; int ui = 0;
    if (!S.next(0, cur)) return;
    f32x4 acc[2][2][4][2];
#pragma unroll
    for (int a = 0; a < 2; ++a)
#pragma unroll
        for (int b = 0; b < 2; ++b)
#pragma unroll
            for (int m = 0; m < 4; ++m)
#pragma unroll
                for (int n = 0; n < 2; ++n) acc[a][b][m][n] = (f32x4){0.f, 0.f, 0.f, 0.f};
    bf16x8 At[4][2], B0[2][2], B1[2][2];
    const char* cA = (const char*)g.A + (size_t)cur.pm * tstep; const char* cB = (const char*)g.Bt + (size_t)cur.pn * tstep;
    S.a_ready(cur);
    if constexpr (SP2) {
        PG8_STAGE(PG8_SB(0, 0), cB, voffB); PG8_STAGE(PG8_SB(0, 1), cB + hstep, voffB); PG8_STAGE(PG8_SA(0, 0), cA, voffA); PG8_STAGE(PG8_SA(0, 1), cA + hstep, voffA);
        if (wr == 1) PG8_BAR;
        PG8_WAIT_V(2); PG8_BAR;
        PG8_STAGE(PG8_SB(1, 0), cB + kstep, voffB); PG8_STAGE(PG8_SA(1, 0), cA + kstep, voffA); PG8_STAGE(PG8_SB(1, 1), cB + hstep + kstep, voffB);
        PG8_WAIT_V(6); PG8_BAR;
    } else {
        PG8_STAGE(PG8_SB(0, 0), cB, voffB); PG8_STAGE(PG8_SA(0, 0), cA, voffA); PG8_STAGE(PG8_SB(0, 1), cB + hstep, voffB); PG8_STAGE(PG8_SA(0, 1), cA + hstep, voffA);
        if (wr == 1) PG8_BAR;
        PG8_WAIT_V(4); PG8_BAR;
        PG8_STAGE(PG8_SB(1, 0), cB + kstep, voffB); PG8_STAGE(PG8_SA(1, 0), cA + kstep, voffA); PG8_STAGE(PG8_SB(1, 1), cB + hstep + kstep, voffB);
        PG8_WAIT_V(6); PG8_BAR;
    }
    for (;;) {
        const bool has_next = S.next(ui + 1, nxt);
        const char* nA = has_next ? (const char*)g.A + (size_t)nxt.pm * tstep : cA; const char* nB = has_next ? (const char*)g.Bt + (size_t)nxt.pn * tstep : cB;
        for (int t = 0; t < nt; t += 2) {
            const bool last = (t == nt - 2);
            const char* a1 = cA + (size_t)(t + 1) * kstep;
            const char* a2 = last ? nA : cA + (size_t)(t + 2) * kstep; const char* b2 = last ? nB : cB + (size_t)(t + 2) * kstep;
            const char* a3 = a2 + kstep; const char* b3 = b2 + kstep;
            if (last && has_next) S.a_ready(nxt);
            if constexpr (SP2) {
            PG8_LDB(B0, 0, 0); PG8_LDB(B1, 0, 1); PG8_SCHED; PG8_LDA(At, 0, 0); PG8_STAGE(PG8_SA(1, 1), a1 + hstep, voffA);
            PG8_WAIT_V(8); PG8_WAIT_L(0); PG8_BAR; PG8_MMA(0, 0, At, B0); PG8_MMA(0, 1, At, B1); PG8_BAR; PG8_SCHED;
            PG8_LDA(At, 0, 1); PG8_STAGE(PG8_SB(0, 0), b2, voffB); PG8_STAGE(PG8_SB(0, 1), b2 + hstep, voffB); PG8_STAGE(PG8_SA(0, 0), a2, voffA);
            PG8_WAIT_V(8); PG8_WAIT_L(0); PG8_BAR; PG8_MMA(1, 0, At, B0); PG8_MMA(1, 1, At, B1); PG8_BAR; PG8_SCHED;
            PG8_LDB(B0, 1, 0); PG8_LDB(B1, 1, 1); PG8_SCHED; PG8_LDA(At, 1, 0); PG8_STAGE(PG8_SA(0, 1), a2 + hstep, voffA);
            PG8_WAIT_V(8); PG8_WAIT_L(0); PG8_BAR; PG8_MMA(0, 0, At, B0); PG8_MMA(0, 1, At, B1); PG8_BAR; PG8_SCHED;
            PG8_LDA(At, 1, 1); PG8_STAGE(PG8_SB(1, 0), b3, voffB); PG8_STAGE(PG8_SB(1, 1), b3 + hstep, voffB); PG8_STAGE(PG8_SA(1, 0), a3, voffA);
            PG8_WAIT_V(8); PG8_WAIT_L(0); PG8_BAR; PG8_MMA(1, 0, At, B0); PG8_MMA(1, 1, At, B1); PG8_BAR; PG8_SCHED;
            } else {
            PG8_LDB(B0, 0, 0); PG8_SCHED; PG8_LDA(At, 0, 0); PG8_STAGE(PG8_SA(1, 1), a1 + hstep, voffA);
            PG8_WAIT_L(8); PG8_BAR; PG8_WAIT_L(0); PG8_MMA(0, 0, At, B0); PG8_BAR; PG8_SCHED;
            PG8_LDB(B1, 0, 1); PG8_STAGE(PG8_SB(0, 0), b2, voffB);
            PG8_BAR; PG8_WAIT_L(0); PG8_MMA(0, 1, At, B1); PG8_BAR;
            PG8_LDA(At, 0, 1); PG8_STAGE(PG8_SA(0, 0), a2, voffA);
            PG8_BAR; PG8_WAIT_L(0); PG8_MMA(1, 0, At, B0); PG8_BAR; PG8_SCHED;
            PG8_STAGE(PG8_SB(0, 1), b2 + hstep, voffB);
            PG8_WAIT_V(6); PG8_BAR; PG8_MMA(1, 1, At, B1); PG8_BAR;
            PG8_LDB(B0, 1, 0); PG8_SCHED; PG8_LDA(At, 1, 0); PG8_STAGE(PG8_SA(0, 1), a2 + hstep, voffA);
            PG8_WAIT_L(8); PG8_BAR; PG8_WAIT_L(0); PG8_MMA(0, 0, At, B0); PG8_BAR; PG8_SCHED;
            PG8_LDB(B1, 1, 1); PG8_STAGE(PG8_SB(1, 0), b3, voffB);
            PG8_BAR; PG8_WAIT_L(0); PG8_MMA(0, 1, At, B1); PG8_BAR;
            PG8_LDA(At, 1, 1); PG8_STAGE(PG8_SA(1, 0), a3, voffA);
            PG8_BAR; PG8_WAIT_L(0); PG8_MMA(1, 0, At, B0); PG8_BAR; PG8_SCHED;
            PG8_STAGE(PG8_SB(1, 1), b3 + hstep, voffB);
            PG8_WAIT_V(6); PG8_BAR; PG8_MMA(1, 1, At, B1); PG8_BAR;
            }
        }
        if constexpr (ALIGN_EPI) { if (wr == 0) PG8_BAR; }
        if constexpr (!Epi::AFTER_DRAIN) { E(acc, cur, wr, wc, fr, fq); S.done(cur); }
        if (!has_next) break;
#pragma unroll
        for (int a = 0; a < 2; ++a)
#pragma unroll
            for (int b = 0; b < 2; ++b)
#pragma unroll
                for (int m = 0; m < 4; ++m)
#pragma unroll
                    for (int n = 0; n < 2; ++n) acc[a][b][m][n] = (f32x4){0.f, 0.f, 0.f, 0.f};
        cur = nxt; cA = nA; cB = nB; ++ui;
        if constexpr (ALIGN_EPI) { if (wr == 1) PG8_BAR; }
    }
    PG8_WAIT_V(0);
    if constexpr (!ALIGN_EPI) { if (wr == 0) PG8_BAR; }
    PG8_BAR;
    if constexpr (Epi::AFTER_DRAIN) { E.fused(acc, cur, wr, wc, fr, fq, lds, wid, lane); S.done(cur); }
#undef PG8_SA
#undef PG8_SB
#undef PG8_STAGE
#undef PG8_LDA
#undef PG8_LDB
#undef PG8_MMA
#undef PG8_WAIT_V
#undef PG8_WAIT_L
#undef PG8_BAR
#undef PG8_SCHED
}
}

#ifndef PG8_SP2
#define PG8_SP2 true
#endif
#ifndef PG8_ALIGN
#define PG8_ALIGN true
#endif
#define GAS __attribute__((address_space(1)))
#define LAS __attribute__((address_space(3)))
typedef float f32x4 __attribute__((ext_vector_type(4)));

#define XB_TMO      128
#define XB_XCNT(j)  (256  + 64 * (j))
#define XB_XSUB(j)  (1280 + 64 * (j))
#define XB_XGEN(j)  (2304 + 64 * (j))
#define XB_TOP      3328
#define XB_TOPGEN   3392
#define XCD_BAR_WORDS 3456
#define XB_SPIN_CAP (1u << 18)

__device__ __forceinline__ unsigned xb_ld(unsigned* p)              { return __hip_atomic_load(p, __ATOMIC_RELAXED, __HIP_MEMORY_SCOPE_AGENT); }
__device__ __forceinline__ unsigned xb_add(unsigned* p, unsigned v) { return __hip_atomic_fetch_add(p, v, __ATOMIC_RELAXED, __HIP_MEMORY_SCOPE_AGENT); }
__device__ __forceinline__ unsigned xb_xcc_id() { return (unsigned)__builtin_amdgcn_s_getreg((3 << 11) | 20) & 0xFu; }
#define XB_SPIN(cond, bar) do { unsigned _sp = 0; while (cond) { __builtin_amdgcn_s_sleep(1); \
    if ((++_sp & 255u) == 0u) { if (xb_ld(&(bar)[XB_TMO])) break; if (_sp > XB_SPIN_CAP) { atomicAdd(&(bar)[XB_TMO], 1u); break; } } } } while (0)

struct XcdBarrier { unsigned* bar; unsigned x; volatile LAS unsigned* st; };

__device__ __forceinline__ XcdBarrier xcd_barrier_post(unsigned* bar, volatile LAS unsigned* st, int wave_id) {
    XcdBarrier b; b.bar = bar; b.x = xb_xcc_id(); b.st = st;
    if (wave_id == 0 && lane_now() == 0) (void)xb_add(&bar[XB_XCNT(b.x)], 1u);
    return b;
}
__device__ __forceinline__ void xcd_barrier_complete(unsigned* bar, unsigned x, unsigned& nloc, unsigned& nx) {
    const unsigned G = gridDim.x * gridDim.y * gridDim.z;
    unsigned sum, cnt, mine, sp = 0u;
    for (;;) {
        sum = 0u; cnt = 0u; mine = 0u;
#pragma unroll
        for (unsigned j = 0; j < 16; ++j) { const unsigned c = xb_ld(&bar[XB_XCNT(j)]); sum += c; cnt += (c > 0u) ? 1u : 0u; mine = (j == x) ? c : mine; }
        if (sum == G) break;
        __builtin_amdgcn_s_sleep(1);
        if ((++sp & 255u) == 0u) { if (xb_ld(&bar[XB_TMO])) break; if (sp > XB_SPIN_CAP) { atomicAdd(&bar[XB_TMO], 1u); break; } }
    }
    nloc = mine > 0u ? mine : 1u; nx = cnt > 0u ? cnt : 1u;
}
__device__ __forceinline__ void xcd_barrier(const XcdBarrier& b, int wave_id) {
    asm volatile("s_waitcnt vmcnt(0)" ::: "memory");
    __syncthreads();
    if (wave_id == 0 && lane_now() == 0) {
        unsigned* bar = b.bar;
        __builtin_amdgcn_s_waitcnt(0);
        unsigned nloc = b.st[0], nx = b.st[1];
        if (nloc == 0u) { xcd_barrier_complete(bar, b.x, nloc, nx); b.st[0] = nloc; b.st[1] = nx; }
        const unsigned old = xb_add(&bar[XB_XSUB(b.x)], 1u);
        const unsigned gen = old / nloc;
        if (old + 1u == (gen + 1u) * nloc) {
            __builtin_amdgcn_fence(__ATOMIC_RELEASE, "agent");
            asm volatile("s_waitcnt vmcnt(0)" ::: "memory");
            const unsigned og = xb_add(&bar[XB_TOP], 1u);
            const unsigned tg = og / nx;
            if (og + 1u == (tg + 1u) * nx) xb_add(&bar[XB_TOPGEN], 1u);
            else XB_SPIN(xb_ld(&bar[XB_TOPGEN]) == tg, bar);
            __builtin_amdgcn_fence(__ATOMIC_ACQUIRE, "agent");
            xb_add(&bar[XB_XGEN(b.x)], 1u);
            asm volatile("s_waitcnt vmcnt(0)" ::: "memory");
        } else {
            XB_SPIN(xb_ld(&bar[XB_XGEN(b.x)]) == gen, bar);
            __builtin_amdgcn_fence(__ATOMIC_ACQUIRE, "agent");
            asm volatile("s_waitcnt vmcnt(0)" ::: "memory");
        }
    }
    __syncthreads();
}


__device__ __forceinline__ void sub_barrier(unsigned* ctr, unsigned target, int wave_id) {
    asm volatile("s_waitcnt vmcnt(0)" ::: "memory");
    __syncthreads();
    if (wave_id == 0 && lane_now() == 0) {
        __builtin_amdgcn_fence(__ATOMIC_RELEASE, "agent");
        asm volatile("s_waitcnt vmcnt(0)" ::: "memory");
        (void)xb_add(ctr, 1u);
        unsigned sp = 0u;
        while (xb_ld(ctr) < target) { __builtin_amdgcn_s_sleep(2); if (++sp > (1u << 22)) break; }
        __builtin_amdgcn_fence(__ATOMIC_ACQUIRE, "agent");
        asm volatile("s_waitcnt vmcnt(0)" ::: "memory");
    }
    __syncthreads();
}
#include <hip/hip_bf16.h>
#include <cmath>
namespace attn_body {
using bf16=__hip_bfloat16;
using bf16x8=__attribute__((ext_vector_type(8)))short;
using s16x4=__attribute__((ext_vector_type(4)))short;
using f32x16=__attribute__((ext_vector_type(16)))float;
using u32x4=__attribute__((ext_vector_type(4)))unsigned;
constexpr int BATCH=8,NHEAD=16,SEQ=2048,D=64,DM=NHEAD*D;
constexpr int NW=8,QBLK=32,QB=QBLK*NW,KVBLK=64,NQB=SEQ/QB;
constexpr int ATTN_PITCH=DM, ATTN_UNIT_ROWS=QB;
__device__ __forceinline__ int crow(int r,int hi){return (r&3)+8*(r>>2)+4*hi;}
#define SBAR() __builtin_amdgcn_sched_barrier(0)
__device__ __forceinline__ void cmask(f32x16&p0,f32x16&p1,int jb,int qrel,int hi){
  const float NEG=-INFINITY; int kb=64*jb+4*hi;
  #pragma unroll
  for(int r=0;r<16;++r){int kv=kb+(r&3)+8*(r>>2); if(kv>qrel)p0[r]=NEG; if(kv+32>qrel)p1[r]=NEG;}
}

constexpr int NSLOT=3, SLOTB=8192;
constexpr int LDS_K=0, LDS_V=NSLOT*SLOTB, LDS_WS=2*NSLOT*SLOTB, LDS_OST=LDS_WS+NW*64*4, LDS_BIAS=LDS_OST+NW*4096, LDS_BYTES=LDS_BIAS+SEQ*8;
constexpr float C2=0.125f*1.4426950408889634f;
__device__ __forceinline__ void glds16(const void*gsrc,unsigned lds_dst){unsigned keep;
  asm volatile("s_mov_b32 %0, m0\n\ts_mov_b32 m0, %2\n\ts_nop 0\n\tglobal_load_lds_dwordx4 %1, off\n\ts_mov_b32 m0, %0":"=&s"(keep):"v"(gsrc),"s"(lds_dst):"memory");}
__device__ __forceinline__ float max3f(float a,float b,float c){float r;asm("v_max3_f32 %0, %1, %2, %3":"=v"(r):"v"(a),"v"(b),"v"(c));return r;}
__device__ __forceinline__ float max2f(float a,float b){float r;asm("v_max_f32_e32 %0, %1, %2":"=v"(r):"v"(a),"v"(b));return r;}
__device__ __forceinline__ float fadd_s(float a,float b){float r;asm("v_add_f32_e32 %0, %1, %2":"=v"(r):"v"(a),"v"(b));return r;}
__device__ __forceinline__ float fsub_s(float a,float b){float r;asm("v_sub_f32_e32 %0, %1, %2":"=v"(r):"v"(a),"v"(b));return r;}
typedef float f32x2_t __attribute__((ext_vector_type(2))); typedef __bf16 bf16x2_t __attribute__((ext_vector_type(2)));
__device__ __forceinline__ unsigned cvtpk_s(float lo,float hi){f32x2_t v={lo,hi};bf16x2_t b=__builtin_convertvector(v,bf16x2_t);return __builtin_bit_cast(unsigned,b);}
#define WAIT_BAR(N) asm volatile("s_waitcnt vmcnt(" #N ") lgkmcnt(0)\n\ts_barrier":::"memory")

__device__ __forceinline__ void qkt(f32x16&p0,f32x16&p1,const char*Kslot,const bf16x8*qr,int r32,int hi,bf16x8 bf0,bf16x8 bf1,bf16x8 qone){
  const char*kb=Kslot+hi*1024+r32*16;
  #pragma unroll
  for(int d0=0;d0<4;++d0){
    const bf16x8 b0=*reinterpret_cast<const bf16x8*>(kb+d0*2048);
    const bf16x8 b1=*reinterpret_cast<const bf16x8*>(kb+d0*2048+512);
    if(d0==0){p0=__builtin_amdgcn_mfma_f32_32x32x16_bf16(b0,qr[0],(f32x16){},0,0,0);p1=__builtin_amdgcn_mfma_f32_32x32x16_bf16(b1,qr[0],(f32x16){},0,0,0);}
    else{p0=__builtin_amdgcn_mfma_f32_32x32x16_bf16(b0,qr[d0],p0,0,0,0);p1=__builtin_amdgcn_mfma_f32_32x32x16_bf16(b1,qr[d0],p1,0,0,0);}}
  p0=__builtin_amdgcn_mfma_f32_32x32x16_bf16(bf0,qone,p0,0,0,0);p1=__builtin_amdgcn_mfma_f32_32x32x16_bf16(bf1,qone,p1,0,0,0);
}
typedef __attribute__((address_space(3))) const char* lds_cptr;
typedef short v4i16_t __attribute__((ext_vector_type(4)));
__device__ __forceinline__ void kload8(bf16x8*kf,lds_cptr kp){
  kf[0]=*(const __attribute__((address_space(3))) bf16x8*)(kp);      kf[1]=*(const __attribute__((address_space(3))) bf16x8*)(kp+512);
  kf[2]=*(const __attribute__((address_space(3))) bf16x8*)(kp+2048); kf[3]=*(const __attribute__((address_space(3))) bf16x8*)(kp+2560);
  kf[4]=*(const __attribute__((address_space(3))) bf16x8*)(kp+4096); kf[5]=*(const __attribute__((address_space(3))) bf16x8*)(kp+4608);
  kf[6]=*(const __attribute__((address_space(3))) bf16x8*)(kp+6144); kf[7]=*(const __attribute__((address_space(3))) bf16x8*)(kp+6656);
}
__device__ __forceinline__ void kload2(bf16x8*kf,lds_cptr kp,int j){ kf[2*j]=*(const __attribute__((address_space(3))) bf16x8*)(kp+j*2048); kf[2*j+1]=*(const __attribute__((address_space(3))) bf16x8*)(kp+j*2048+512); }
__device__ __forceinline__ s16x4 vtr(lds_cptr p){ return __builtin_bit_cast(s16x4,__builtin_amdgcn_ds_read_tr16_b64_v4i16((__attribute__((address_space(3))) v4i16_t*)p)); }
__device__ __forceinline__ float rowmax(const f32x16&p0,const f32x16&p1){
  float a=max3f(p0[0],p0[1],p1[0]),b=max3f(p0[2],p0[3],p1[1]);a=max3f(a,p1[2],p1[3]);
  #pragma unroll
  for(int r=4;r<16;r+=4){a=max3f(a,p0[r],p0[r+1]);b=max3f(b,p0[r+2],p0[r+3]);a=max3f(a,p1[r],p1[r+1]);b=max3f(b,p1[r+2],p1[r+3]);}
  const float m=max2f(a,b);
  auto rr=__builtin_amdgcn_permlane32_swap(__float_as_uint(m),__float_as_uint(m),false,false);
  return max2f(__uint_as_float(rr[0]),__uint_as_float(rr[1]));
}
__device__ __forceinline__ void pv(f32x16*o,int vb,bf16x8 pa0,bf16x8 pa1,bf16x8 pa2,bf16x8 pa3){
  #pragma unroll
  for(int d0=0;d0<2;++d0){s16x4 lo[4],hi[4];
    #pragma unroll
    for(int ks=0;ks<4;++ks){
      asm volatile("ds_read_b64_tr_b16 %0,%1 offset:%c2":"=&v"(lo[ks]):"v"(vb),"i"(d0*4096+ks*1024):"memory");
      asm volatile("ds_read_b64_tr_b16 %0,%1 offset:%c2":"=&v"(hi[ks]):"v"(vb),"i"(d0*4096+ks*1024+512):"memory");}
    asm volatile("s_waitcnt lgkmcnt(0)":::"memory");SBAR();
    #define PK(k) (bf16x8){lo[k][0],lo[k][1],lo[k][2],lo[k][3],hi[k][0],hi[k][1],hi[k][2],hi[k][3]}
    o[d0]=__builtin_amdgcn_mfma_f32_32x32x16_bf16(pa0,PK(0),o[d0],0,0,0);
    o[d0]=__builtin_amdgcn_mfma_f32_32x32x16_bf16(pa1,PK(1),o[d0],0,0,0);
    o[d0]=__builtin_amdgcn_mfma_f32_32x32x16_bf16(pa2,PK(2),o[d0],0,0,0);
    o[d0]=__builtin_amdgcn_mfma_f32_32x32x16_bf16(pa3,PK(3),o[d0],0,0,0);
    #undef PK
  }
}

#ifndef ATTN_STORE16
#define ATTN_STORE16(p,v) (*(u32x4*)(p)=(v))
#endif
template<int THRL> __device__ __forceinline__ void attn_unit(int b,int h,int qb,const bf16*Q,const bf16*__restrict__ K,const bf16*__restrict__ V,bf16*O,const unsigned short*__restrict__ CB,const unsigned short*__restrict__ SBZ,char*shm,const int wid){
  const int lane=lane_now(),r32=lane&31,hi=lane>>5;
  const long rowbase=(long)b*SEQ; const int q0=qb*QB;
  const bf16*Qw=Q+(rowbase+q0+wid*QBLK)*DM+h*D;
  const bf16*Kh=K+rowbase*DM+h*D,*Vh=V+rowbase*DM+h*D;
  const unsigned lds0=(unsigned)(uintptr_t)shm;
  float*wsf=(float*)(shm+LDS_WS)+wid*64;
  const bf16*ksrc=Kh+(long)lane*DM+wid*8;
  const bf16*vsrc=Vh+(long)(16*(wid&3)+(lane>>2))*DM+(wid>>2)*32+(lane&3)*8;
  const unsigned kdst=lds0+LDS_K+wid*1024, vdst=lds0+LDS_V+wid*1024;
  #define DMA_K(t,slot) glds16(ksrc+(long)(t)*KVBLK*DM,(unsigned)__builtin_amdgcn_readfirstlane(kdst+(slot)))
  #define DMA_V(t,slot) glds16(vsrc+(long)(t)*KVBLK*DM,(unsigned)__builtin_amdgcn_readfirstlane(vdst+(slot)))
  const int vb0=(int)(lds0+LDS_V)+((lane>>4)&1)*32+(lane&3)*8+(4*hi+((lane&15)>>2))*64;
  const char*Kbase=shm+LDS_K; bf16x8 kf[8];
  const lds_cptr shm3=(lds_cptr)shm; const lds_cptr kp0=shm3+LDS_K+hi*1024+r32*16; const lds_cptr vp0=shm3+LDS_V+((lane>>4)&1)*32+(lane&3)*8+(4*hi+((lane&15)>>2))*64;
  const int NT=(q0+QB)/KVBLK;
  { const char*cbsrc=(const char*)CB+((long)(b*NHEAD+h)*SEQ)*8+lane*16;
    for(int pc=wid;pc<2*(qb+1);pc+=NW) glds16(cbsrc+pc*1024,(unsigned)__builtin_amdgcn_readfirstlane(lds0+LDS_BIAS+pc*1024)); }
  bf16x8 qone;
  #define MKQB() do{ const float nm_=-mhat; const unsigned h1_=cvtpk_s(nm_,0.f)&0xffffu; const float r1_=nm_-__uint_as_float(h1_<<16); const unsigned h2_=cvtpk_s(r1_,0.f)&0xffffu; \
      const float r2_=r1_-__uint_as_float(h2_<<16); const unsigned h3_=cvtpk_s(r2_,0.f)&0xffffu; u32x4 q_; q_[0]=0x3F803F80u; q_[1]=0x3F80u|(h1_<<16); q_[2]=h2_|(h3_<<16); q_[3]=0u; \
      if(hi!=0){q_[0]=0u;q_[1]=0u;q_[2]=0u;} qone=__builtin_bit_cast(bf16x8,q_); }while(0)
  const lds_cptr bp0=(lds_cptr)shm+LDS_BIAS+r32*8;
  #define BFRAG(t,hf) ({ const s16x4 v_=*(const __attribute__((address_space(3))) s16x4*)(bp0+((t)*64+(hf)*32)*8); (bf16x8){v_[0],v_[1],v_[2],v_[3],0x3F80,0x3F80,0,0}; })
  DMA_K(0,0);DMA_V(0,0);DMA_K(1,SLOTB);
  bf16x8 qr[4];
  #pragma unroll
  for(int d0=0;d0<4;++d0)qr[d0]=*reinterpret_cast<const bf16x8*>(&Qw[(long)r32*DM+d0*16+hi*8]);
  float mhat=0.f,l_reg=0.f;f32x16 o[2];o[0]=f32x16{};o[1]=f32x16{};
  const int qrel=wid*QBLK+r32;
  #define CMASK(P0,P1,t) do{int jb_=(t)-(NT-4); if(jb_>=0)cmask(P0,P1,jb_,qrel,hi);}while(0)
  bool resc=false;
  #define START(P0,P1) do{ const float rm=rowmax(P0,P1); resc=false; \
    { const float dl=rm; mhat=fadd_s(mhat,dl); \
      _Pragma("unroll") for(int r=0;r<16;++r){P0[r]=fsub_s(P0[r],dl);P1[r]=fsub_s(P1[r],dl);} \
      MKQB(); } \
    _Pragma("unroll") for(int r=0;r<16;++r)P0[r]=__builtin_amdgcn_exp2f(P0[r]); }while(0)
  #define RESC() do{ if(resc){ asm volatile("s_waitcnt lgkmcnt(0)":::"memory"); \
      _Pragma("unroll") for(int d_=0;d_<2;++d_) _Pragma("unroll") for(int r=0;r<16;++r)o[d_][r]*=wsf[crow(r,hi)]; } }while(0)
  f32x16 pA0,pA1,pB0,pB1;
  int sl_prev=0,sl_cur=0,sl_next=SLOTB;
  #define ROT() do{sl_prev=sl_cur;sl_cur=sl_next;sl_next=(sl_next==(NSLOT-1)*SLOTB)?0:sl_next+SLOTB;}while(0)
  DMA_K(2,2*SLOTB);
  WAIT_BAR(3);
  MKQB(); qkt(pA0,pA1,Kbase,qr,r32,hi,BFRAG(0,0),BFRAG(0,1),qone);asm volatile("s_nop 15\n\ts_nop 7":"+v"(pA0),"+v"(pA1));CMASK(pA0,pA1,0);
  START(pA0,pA1);
  _Pragma("unroll") for(int r=0;r<16;++r)pA1[r]=__builtin_amdgcn_exp2f(pA1[r]);
  WAIT_BAR(0);
  DMA_K(3,0);DMA_V(1,SLOTB);
  ROT();
  kload8(kf,kp0+sl_cur);
  WAIT_BAR(2);
  s16x4 vlo[8],vhi[8]; u32x4 pw0,pw1,pw2,pw3;
  #define PKW(P,B) cvtpk_s(P[B],P[B+1])
  #define PAF(k) __builtin_bit_cast(bf16x8,pw##k)
  #define VFR(i) (bf16x8){vlo[i][0],vlo[i][1],vlo[i][2],vlo[i][3],vhi[i][0],vhi[i][1],vhi[i][2],vhi[i][3]}
  #define PIN(x) asm volatile("":"+v"(x))
  #define MX3(a,b,c) __builtin_fmaxf(__builtin_fmaxf((a),(b)),(c))
  #define GAPA(MF,A0,A1,A2,A3,W0,W1,PW) do{ MF; sacc+=A0; sacc+=A1; sacc+=A2; sacc+=A3; PIN(sacc); W0; W1; PIN(PW); SBAR(); }while(0)
  #define EX(v) __builtin_amdgcn_exp2f(v)
  #define GAPB(MF,X,B) do{ MF; X[B]=EX(X[B]); X[B+1]=EX(X[B+1]); X[B+2]=EX(X[B+2]); X[B+3]=EX(X[B+3]); PIN(X); SBAR(); }while(0)
  #define VRD(i) do{ vlo[i]=vtr(vp_+(((i)>>2)*4096+((i)&3)*1024)); vhi[i]=vtr(vp_+(((i)>>2)*4096+((i)&3)*1024+512)); }while(0)
  #define KRD(G,j) do{ if(G){ kload2(kf,kp0+sl_next,j); SBAR(); } }while(0)
  #define STEP(C0,C1,P0,P1,t,GK,GV,GL) do{ SBAR(); \
    const lds_cptr vp_=vp0+sl_prev; const bf16x8 bfa_=BFRAG(t,0), bfb_=BFRAG(t,1); \
    VRD(0); SBAR(); float sacc=(P0[0]+P0[1]); \
    GAPA(C0=__builtin_amdgcn_mfma_f32_32x32x16_bf16(kf[0],qr[0],(f32x16){},0,0,0), P0[2],P0[3],P0[4],P0[5],     pw0[0]=PKW(P0,0), pw0[1]=PKW(P0,2), pw0); \
    VRD(4); SBAR(); GAPA(C1=__builtin_amdgcn_mfma_f32_32x32x16_bf16(kf[1],qr[0],(f32x16){},0,0,0), P0[6],P0[7],P0[8],P0[9],     pw0[2]=PKW(P0,4), pw0[3]=PKW(P0,6), pw0); \
    C0=__builtin_amdgcn_mfma_f32_32x32x16_bf16(bfa_,qone,C0,0,0,0); C1=__builtin_amdgcn_mfma_f32_32x32x16_bf16(bfb_,qone,C1,0,0,0); SBAR(); \
    VRD(1); SBAR(); GAPA(C0=__builtin_amdgcn_mfma_f32_32x32x16_bf16(kf[2],qr[1],C0,0,0,0),   P0[10],P0[11],P0[12],P0[13], pw1[0]=PKW(P0,8), pw1[1]=PKW(P0,10), pw1); \
    VRD(5); SBAR(); GAPA(C1=__builtin_amdgcn_mfma_f32_32x32x16_bf16(kf[3],qr[1],C1,0,0,0),   P0[14],P0[15],P1[0],P1[1],   pw1[2]=PKW(P0,12),pw1[3]=PKW(P0,14), pw1); \
    VRD(2); SBAR(); GAPA(C0=__builtin_amdgcn_mfma_f32_32x32x16_bf16(kf[4],qr[2],C0,0,0,0),   P1[2],P1[3],P1[4],P1[5],     pw2[0]=PKW(P1,0), pw2[1]=PKW(P1,2), pw2); \
    VRD(6); SBAR(); GAPA(C1=__builtin_amdgcn_mfma_f32_32x32x16_bf16(kf[5],qr[2],C1,0,0,0),   P1[6],P1[7],P1[8],P1[9],     pw2[2]=PKW(P1,4), pw2[3]=PKW(P1,6), pw2); \
    VRD(3); SBAR(); GAPA(C0=__builtin_amdgcn_mfma_f32_32x32x16_bf16(kf[6],qr[3],C0,0,0,0),   P1[10],P1[11],P1[12],P1[13], pw3[0]=PKW(P1,8), pw3[1]=PKW(P1,10), pw3); \
    VRD(7); SBAR(); GAPA(C1=__builtin_amdgcn_mfma_f32_32x32x16_bf16(kf[7],qr[3],C1,0,0,0),   P1[14],P1[15],0.f,0.f,       pw3[2]=PKW(P1,12),pw3[3]=PKW(P1,14), pw3); \
    l_reg+=sacc; \
    if(GK){DMA_K((t)+3,sl_cur);} if(GV){DMA_V((t)+1,sl_next);} \
    CMASK(C0,C1,t); \
    { float a=MX3(C0[0],C0[1],C1[0]),b=MX3(C0[2],C0[3],C1[1]); a=MX3(a,C1[2],C1[3]); \
      _Pragma("unroll") for(int r=4;r<16;r+=4){a=MX3(a,C0[r],C0[r+1]);b=MX3(b,C0[r+2],C0[r+3]);a=MX3(a,C1[r],C1[r+1]);b=MX3(b,C1[r+2],C1[r+3]);} \
      float rm=__builtin_fmaxf(a,b); { auto rr=__builtin_amdgcn_permlane32_swap(__float_as_uint(rm),__float_as_uint(rm),false,false); rm=__builtin_fmaxf(__uint_as_float(rr[0]),__uint_as_float(rr[1])); } \
      resc=false; \
      if(__builtin_expect(__any(rm>(float)THRL),0)){ const float dl=__builtin_fmaxf(rm,0.f); mhat+=dl; \
        _Pragma("unroll") for(int r=0;r<16;++r){C0[r]-=dl;C1[r]-=dl;} \
        MKQB(); \
        const float f=__builtin_amdgcn_exp2f(-dl); l_reg*=f; if(hi==0)wsf[r32]=f; resc=true; } } \
    SBAR(); \
    GAPB(o[0]=__builtin_amdgcn_mfma_f32_32x32x16_bf16(PAF(0),VFR(0),o[0],0,0,0), C0,0); \
    GAPB(o[1]=__builtin_amdgcn_mfma_f32_32x32x16_bf16(PAF(0),VFR(4),o[1],0,0,0), C0,4); \
    KRD(GL,0); GAPB(o[0]=__builtin_amdgcn_mfma_f32_32x32x16_bf16(PAF(1),VFR(1),o[0],0,0,0), C0,8); \
    KRD(GL,1); GAPB(o[1]=__builtin_amdgcn_mfma_f32_32x32x16_bf16(PAF(1),VFR(5),o[1],0,0,0), C0,12); \
    KRD(GL,2); GAPB(o[0]=__builtin_amdgcn_mfma_f32_32x32x16_bf16(PAF(2),VFR(2),o[0],0,0,0), C1,0); \
    KRD(GL,3); GAPB(o[1]=__builtin_amdgcn_mfma_f32_32x32x16_bf16(PAF(2),VFR(6),o[1],0,0,0), C1,4); \
    GAPB(o[0]=__builtin_amdgcn_mfma_f32_32x32x16_bf16(PAF(3),VFR(3),o[0],0,0,0), C1,8); \
    GAPB(o[1]=__builtin_amdgcn_mfma_f32_32x32x16_bf16(PAF(3),VFR(7),o[1],0,0,0), C1,12); \
    }while(0)
  int t=1;
  #undef CMASK
  #define CMASK(P0,P1,t) do{}while(0)
  for(;t+5<NT;t+=2){
    STEP(pB0,pB1,pA0,pA1,t,true,true,true);     WAIT_BAR(2); RESC(); ROT();
    STEP(pA0,pA1,pB0,pB1,t+1,true,true,true);   WAIT_BAR(2); RESC(); ROT();
  }
  #undef CMASK
  #define CMASK(P0,P1,t) do{int jb_=(t)-(NT-4); if(jb_>=0)cmask(P0,P1,jb_,qrel,hi);}while(0)
  #define ENDW(tt) do{ if((tt)+3<NT){WAIT_BAR(2);} else if((tt)+2<NT){WAIT_BAR(1);} else {WAIT_BAR(0);} }while(0)
  for(;t+1<NT;t+=2){
    STEP(pB0,pB1,pA0,pA1,t,(t+3<NT),(t+1<NT),(t+1<NT));       ENDW(t);   RESC(); ROT();
    STEP(pA0,pA1,pB0,pB1,t+1,(t+4<NT),(t+2<NT),(t+2<NT));     ENDW(t+1); RESC(); ROT();
  }
  STEP(pB0,pB1,pA0,pA1,NT-1,false,false,false); RESC();
  { float sacc=pB0[0]+pB0[1]; _Pragma("unroll") for(int r=2;r<16;++r)sacc+=pB0[r]; _Pragma("unroll") for(int r=0;r<16;++r)sacc+=pB1[r]; l_reg+=sacc;
    pw0=(u32x4){PKW(pB0,0),PKW(pB0,2),PKW(pB0,4),PKW(pB0,6)};pw1=(u32x4){PKW(pB0,8),PKW(pB0,10),PKW(pB0,12),PKW(pB0,14)};pw2=(u32x4){PKW(pB1,0),PKW(pB1,2),PKW(pB1,4),PKW(pB1,6)};pw3=(u32x4){PKW(pB1,8),PKW(pB1,10),PKW(pB1,12),PKW(pB1,14)};
    SBAR(); pv(o,vb0+sl_cur,PAF(0),PAF(1),PAF(2),PAF(3)); }
  #undef PKW
  #undef PAF
  #undef VFR
  #undef PIN
  #undef MX3
  #undef GAPA
  #undef GAPB
  #undef EX
  #undef VRD
  #undef KRD
  #undef STEP
  #undef ENDW
  {auto rr=__builtin_amdgcn_permlane32_swap(__float_as_uint(l_reg),__float_as_uint(l_reg),false,false);l_reg=__uint_as_float(rr[0])+__uint_as_float(rr[1]);}
  if(hi==0)wsf[32+r32]=l_reg;asm volatile("s_waitcnt lgkmcnt(0)":::"memory");
  float rli[16];
  #pragma unroll
  for(int r=0;r<16;++r)rli[r]=__builtin_amdgcn_rcpf(wsf[32+crow(r,hi)]);
  bf16*Ow=O+(rowbase+q0+wid*QBLK)*DM+h*D;
  { bf16*stg=(bf16*)(shm+LDS_OST)+wid*2048;
    #pragma unroll
    for(int r=0;r<16;++r){const int orow=crow(r,hi);
      #pragma unroll
      for(int d0=0;d0<2;++d0)stg[orow*64+d0*32+r32]=__float2bfloat16(o[d0][r]*rli[r]);}
    asm volatile("s_waitcnt lgkmcnt(0)":::"memory");
    const unsigned short*Gw=SBZ+(rowbase+q0+wid*QBLK)*DM+h*D;
    #pragma unroll
    for(int i=0;i<4;++i){const int row=i*8+(lane>>3),ch=lane&7; const u32x4 v=*(const u32x4*)(stg+row*64+ch*8); const u32x4 gz=*(const u32x4*)(Gw+(long)row*DM+ch*8); u32x4 w;
      #pragma unroll
      for(int e=0;e<4;++e){ const float lo=__uint_as_float(v[e]<<16)*__uint_as_float(gz[e]<<16), hi_=__uint_as_float(v[e]&0xffff0000u)*__uint_as_float(gz[e]&0xffff0000u); w[e]=cvtpk_s(lo,hi_); }
      ATTN_STORE16(Ow+(long)row*DM+ch*8,w);} }
  asm volatile("s_waitcnt lgkmcnt(0)\n\ts_barrier":::"memory");
  #undef BFRAG
  #undef MKQB
  #undef DMA_K
  #undef DMA_V
  #undef CMASK
  #undef START
  #undef RESC
  #undef ROT
}
constexpr int ATTN_LDS_BYTES=LDS_BYTES;
#undef SBAR
#undef WAIT_BAR
}
namespace ml {
using bf16x8 = __attribute__((ext_vector_type(8))) short;
using s16x4 = __attribute__((ext_vector_type(4))) short;
using f32x16 = __attribute__((ext_vector_type(16))) float;
using f32x4 = __attribute__((ext_vector_type(4))) float;
using u32x4 = __attribute__((ext_vector_type(4))) unsigned;
using u32x2 = __attribute__((ext_vector_type(2))) unsigned;
typedef short v4i16_t __attribute__((ext_vector_type(4)));
#define MLAS __attribute__((address_space(3)))
constexpr int SEQ = 2048, NCH = SEQ / 64, DMODEL = 1024;
constexpr int QC_RS = 272, KW_RS = 320, V_RS = 576, P_RS = 144, ST_RS = 80;
constexpr int L_QC = 0, L_KC = L_QC + 64 * QC_RS, L_KW = L_KC + 64 * QC_RS, L_V = L_KW + 64 * KW_RS, L_P = L_V + 64 * V_RS, L_VEC = L_P + 64 * P_RS;
constexpr int V_US = 0, V_UL = 64, V_WI = 128, V_EM = 192, V_WK = 256, V_RS2 = 320  , V_QN = 448, V_SSQ = 512  , V_NST = 1024  , V_CW = 1152  , V_WS = 2432  , V_END = 3456;
constexpr int L_STG = L_VEC + V_END * 4, STG_W = 32 * ST_RS  , L_END = L_STG + 8 * STG_W;
static_assert(L_END <= 139264, "mLSTM LDS map");
constexpr float L2E = 1.4426950408889634f;

__device__ __forceinline__ float bflo(unsigned w) { return __uint_as_float(w << 16); }
__device__ __forceinline__ float bfhi(unsigned w) { return __uint_as_float(w & 0xffff0000u); }
typedef float f32x2_t __attribute__((ext_vector_type(2))); typedef __bf16 bf16x2_t __attribute__((ext_vector_type(2)));
__device__ __forceinline__ unsigned pkbf(float lo, float hi) { f32x2_t v = {lo, hi}; bf16x2_t b = __builtin_convertvector(v, bf16x2_t); return __builtin_bit_cast(unsigned, b); }
__device__ __forceinline__ s16x4 trrd(const MLAS unsigned char* p) { return __builtin_bit_cast(s16x4, __builtin_amdgcn_ds_read_tr16_b64_v4i16((MLAS v4i16_t*)p)); }
__device__ __forceinline__ bf16x8 cat8(s16x4 a, s16x4 b) { return (bf16x8){a[0], a[1], a[2], a[3], b[0], b[1], b[2], b[3]}; }
__device__ __forceinline__ int crow(int r, int hi) { return (r & 3) + 8 * (r >> 2) + 4 * hi; }
template <int CTRL, int RM = 0xf, int BM = 0xf> __device__ __forceinline__ float dpp_mov(float old, float x) { return __builtin_bit_cast(float, __builtin_amdgcn_update_dpp(__builtin_bit_cast(int, old), __builtin_bit_cast(int, x), CTRL, RM, BM, false)); }
__device__ __forceinline__ float scan_add64(float x) { x += dpp_mov<0x111>(0.f, x); x += dpp_mov<0x112>(0.f, x); x += dpp_mov<0x114>(0.f, x); x += dpp_mov<0x118>(0.f, x); x += dpp_mov<0x142, 0xa>(0.f, x); x += dpp_mov<0x143, 0xc>(0.f, x); return x; }
__device__ __forceinline__ float scan_max64(float x) { const float ninf = -INFINITY; x = fmaxf(x, dpp_mov<0x111>(ninf, x)); x = fmaxf(x, dpp_mov<0x112>(ninf, x)); x = fmaxf(x, dpp_mov<0x114>(ninf, x)); x = fmaxf(x, dpp_mov<0x118>(ninf, x));
    x = fmaxf(x, dpp_mov<0x142, 0xa>(ninf, x)); x = fmaxf(x, dpp_mov<0x143, 0xc>(ninf, x)); return x; }
__device__ __forceinline__ float sum_row16(float x) { x += dpp_mov<0x111>(0.f, x); x += dpp_mov<0x112>(0.f, x); x += dpp_mov<0x114>(0.f, x); x += dpp_mov<0x118>(0.f, x); return x; }
__device__ __forceinline__ float sum_half32(float x) { x = sum_row16(x); x += dpp_mov<0x142, 0xa>(0.f, x); return x; }
#define ML_SBAR() __builtin_amdgcn_sched_barrier(0)
__device__ __forceinline__ void touch_lds4(const void* gsrc, unsigned lds_dst) { unsigned keep;
    asm volatile("s_mov_b32 %0, m0\n\ts_mov_b32 m0, %2\n\ts_nop 0\n\tglobal_load_lds_dword %1, off\n\ts_mov_b32 m0, %0" : "=&s"(keep) : "v"(gsrc), "s"(lds_dst) : "memory"); }
#define ML_BAR() do { asm volatile("s_waitcnt lgkmcnt(0)" ::: "memory"); __builtin_amdgcn_s_barrier(); asm volatile("" ::: "memory"); } while (0)

__device__ __forceinline__ void mlstm_unit(const unsigned short* __restrict__ AQK, const unsigned short* __restrict__ AV, unsigned short* HA, const float* __restrict__ LI, const float* __restrict__ LFA,
                                           const float* __restrict__ conv_w, const float* __restrict__ conv_b, const float* __restrict__ hn_g, MLAS unsigned char* lds, int unit, const int wid, unsigned long long* tsp) {
    const int b = unit >> 2, h = unit & 3;
    MLAS float* vec = (MLAS float*)(lds + L_VEC);
    const size_t row0 = (size_t)b * SEQ;
    { const int lane = lane_now(), tid = wid * 64 + lane;
    for (int i = tid; i < 5 * 256; i += 512) { const int kk = i >> 8, c = i & 255; const int ch = (c < 128) ? (h * 128 + c) : (512 + h * 128 + (c - 128)); vec[V_CW + i] = (kk < 4) ? conv_w[kk * 1024 + ch] : conv_b[ch]; }
    if (tid < 128) vec[V_NST + tid] = 0.f;
    if (tid < 256) vec[V_WS + tid] = hn_g[h * 256 + tid]; }
    f32x16 C[4];
#pragma unroll
    for (int kt = 0; kt < 4; ++kt) C[kt] = (f32x16){};
    float mprev = 0.f;
    u32x4 raw[7], vv[4]; float lf, li;
#define ML_PREFETCH(T0) do { const int lane_ = lane_now(), tid_ = wid * 64 + lane_, rg_ = tid_ >> 5, cc_ = tid_ & 31; const int gcol_ = (cc_ < 16) ? (h * 128 + 8 * cc_) : (512 + h * 128 + 8 * (cc_ - 16)); \
        _Pragma("unroll") for (int i = 0; i < 7; ++i) { const int t = (T0) + 4 * rg_ - 3 + i; const u32x4 ld_ = *(const u32x4*)(AQK + (row0 + (t < 0 ? 0 : t)) * DMODEL + gcol_); const unsigned keep_ = (t < 0) ? 0u : 0xffffffffu; \
            raw[i] = (u32x4){ld_[0] & keep_, ld_[1] & keep_, ld_[2] & keep_, ld_[3] & keep_}; }     \
        _Pragma("unroll") for (int i = 0; i < 4; ++i) { const int id = tid_ + 512 * i, vr = id >> 5, vc = id & 31; vv[i] = *(const u32x4*)(AV + (row0 + (T0) + vr) * DMODEL + h * 256 + 8 * vc); } \
        lf = LFA[(row0 + (T0) + lane_) * 4 + h]; li = LI[(row0 + (T0) + lane_) * 4 + h]; } while (0)
    ML_PREFETCH(0);
    ML_BAR();
    f32x16 num[2]; u32x2 gz[2][4];
#define ML_OUTPUT(TB) do { \
          \
        { \
_Pragma("unroll") \
            for (int rt = 0; rt < 2; ++rt) { \
                float s8 = 0.f; \
_Pragma("unroll") \
                for (int w8 = 0; w8 < 8; ++w8) s8 += vec[V_SSQ + 64 * w8 + 32 * rt + r32]; \
                const float rstd = 1.f / sqrtf(s8 * (1.f / 256.f) + 1e-6f); \
_Pragma("unroll") \
                for (int g4 = 0; g4 < 4; ++g4) { const f32x4 hg = *(const MLAS f32x4*)(vec + V_WS + 32 * wid + 8 * g4 + 4 * hi); const u32x2 gzz = gz[rt][g4]; \
                    const float v0 = num[rt][4 * g4] * rstd * hg[0] * bflo(gzz[0]), v1 = num[rt][4 * g4 + 1] * rstd * hg[1] * bfhi(gzz[0]), v2 = num[rt][4 * g4 + 2] * rstd * hg[2] * bflo(gzz[1]), v3 = num[rt][4 * g4 + 3] * rstd * hg[3] * bfhi(gzz[1]); \
                    *(u32x2*)(HA + (row0 + (TB) + 32 * rt + r32) * DMODEL + h * 256 + 32 * wid + 8 * g4 + 4 * hi) = (u32x2){pkbf(v0, v1), pkbf(v2, v3)}; } \
            } \
        } \
        } while (0)
#ifdef PROBE
    unsigned long long tacc0 = 0, tacc1 = 0, tacc2 = 0, tacc3 = 0, tacc4 = 0, tacc5 = 0, tlast = __builtin_amdgcn_s_memrealtime();
#define ML_T(k) do { const unsigned long long t_ = __builtin_amdgcn_s_memrealtime(); tacc##k += t_ - tlast; tlast = t_; } while (0)
#else
#define ML_T(k) do {} while (0)
#endif
    for (int j = 0; j < NCH; ++j) {
        const int t0 = 64 * j;
        const int lane = lane_now(), tid = wid * 64 + lane, r32 = lane & 31, hi = lane >> 5;
        const int rg = tid >> 5, cc = tid & 31;
        if (j + 2 < NCH && wid < 6) {
            const int tt = t0 + 128 + lane;
            const unsigned short* base = (wid < 2) ? AQK + (row0 + tt) * DMODEL + ((wid & 1) ? 512 : 0) + h * 128 : ((wid < 4) ? AV : HA) + (row0 + tt) * DMODEL + h * 256 + (wid & 1) * 128;
            const unsigned dmy = (unsigned)__builtin_amdgcn_readfirstlane((int)(unsigned)(uintptr_t)(lds + L_STG + wid * 512));
            touch_lds4(base, dmy); touch_lds4(base + 64, dmy + 256);
        }
        const float bc = scan_add64(lf);
        const float g = __builtin_bit_cast(float, __builtin_amdgcn_readlane(__builtin_bit_cast(int, bc), 63));
        const float a = li - bc; const float cm = scan_max64(a);
        const float mrow = bc + fmaxf(mprev, cm);
        const float cm63 = __builtin_bit_cast(float, __builtin_amdgcn_readlane(__builtin_bit_cast(int, cm), 63));
        const float mnew = fmaxf(g + mprev, g + cm63);
        const float wk = __expf(g + a - mnew), decay = __expf(g + mprev - mnew);
        if (wid == 0) { vec[V_US + lane] = a * L2E; vec[V_UL + lane] = (bc - mrow) * L2E; vec[V_WI + lane] = __expf(bc + mprev - mrow); vec[V_EM + lane] = __expf(-mrow); vec[V_WK + lane] = wk; }
        {
#pragma unroll
            for (int i = 0; i < 4; ++i) { const int id = tid + 512 * i, vr = id >> 5, vc = id & 31; *(MLAS u32x4*)(lds + L_V + vr * V_RS + vc * 16) = vv[i]; }
            float wkr[4];
#pragma unroll
            for (int i = 0; i < 4; ++i) wkr[i] = __shfl(wk, 4 * rg + i);
#pragma unroll
            for (int hc = 0; hc < 2; ++hc) {
                const MLAS f32x4* cw = (const MLAS f32x4*)(vec + V_CW + 8 * cc + 4 * hc);
                f32x4 wt[5];
#pragma unroll
                for (int kk = 0; kk < 5; ++kk) wt[kk] = cw[kk * 64];
#pragma unroll
                for (int i = 0; i < 4; ++i) {
                    const int rr = 4 * rg + i; f32x4 y = wt[4];
#pragma unroll
                    for (int kk = 0; kk < 4; ++kk) { const unsigned w0 = raw[i + kk][2 * hc], w1 = raw[i + kk][2 * hc + 1]; y[0] += wt[kk][0] * bflo(w0); y[1] += wt[kk][1] * bfhi(w0); y[2] += wt[kk][2] * bflo(w1); y[3] += wt[kk][3] * bfhi(w1); }
#pragma unroll
                    for (int e = 0; e < 4; ++e) y[e] = y[e] * __builtin_amdgcn_rcpf(1.f + __expf(-y[e]));
                    if (cc < 16) { u32x2 o; o[0] = pkbf(y[0], y[1]); o[1] = pkbf(y[2], y[3]); *(MLAS u32x2*)(lds + L_QC + rr * QC_RS + cc * 16 + hc * 8) = o; }
                    else { const float ksc = 0.08838834764831845f; y = y * ksc; u32x2 o, ow; o[0] = pkbf(y[0], y[1]); o[1] = pkbf(y[2], y[3]); y = y * wkr[i]; ow[0] = pkbf(y[0], y[1]); ow[1] = pkbf(y[2], y[3]);
                        *(MLAS u32x2*)(lds + L_KC + rr * QC_RS + (cc - 16) * 16 + hc * 8) = o; *(MLAS u32x2*)(lds + L_KW + rr * KW_RS + (cc - 16) * 16 + hc * 8) = ow; }
                }
            }
        }
        if (j > 0) ML_OUTPUT(t0 - 64);
        ML_BAR();
        ML_T(0);
        {
            const int rb = wid >> 1, fr = lane & 15, kg = lane >> 4; float rsum[4] = {0.f, 0.f, 0.f, 0.f};
            bf16x8 qa[4];
#pragma unroll
            for (int ks = 0; ks < 4; ++ks) qa[ks] = *(const MLAS bf16x8*)(lds + L_QC + (16 * rb + fr) * QC_RS + (32 * ks + 8 * kg) * 2);
#pragma unroll
            for (int ct = 0; ct < 2; ++ct) {
                const int cbk = 2 * (wid & 1) + ct;
                f32x4 d = (f32x4){0.f, 0.f, 0.f, 0.f};
                if (cbk <= rb) {
#pragma unroll
                    for (int ks = 0; ks < 4; ++ks) { const bf16x8 kb = *(const MLAS bf16x8*)(lds + L_KC + (16 * cbk + fr) * QC_RS + (32 * ks + 8 * kg) * 2); d = __builtin_amdgcn_mfma_f32_16x16x32_bf16(qa[ks], kb, d, 0, 0, 0); }
                }
                const int s_ = 16 * cbk + fr; const float us = vec[V_US + s_];
#pragma unroll
                for (int r = 0; r < 4; ++r) { const int l_ = 16 * rb + 4 * kg + r; const float w = (s_ <= l_) ? __builtin_amdgcn_exp2f(vec[V_UL + l_] + us) : 0.f; const float p = d[r] * w;
                    const unsigned pb = pkbf(p, 0.f) & 0xffffu; *(MLAS unsigned short*)(lds + L_P + l_ * P_RS + s_ * 2) = (unsigned short)pb; rsum[r] += __uint_as_float(pb << 16); }
            }
#pragma unroll
            for (int r = 0; r < 4; ++r) { const float v = sum_row16(rsum[r]); if (fr == 15) vec[V_RS2 + (wid & 1) * 64 + 16 * rb + 4 * kg + r] = v; }
            { const int rr = 8 * wid + (lane >> 3), sg = lane & 7; float s = 0.f;
#pragma unroll
              for (int q2 = 0; q2 < 2; ++q2) { const u32x4 qv = *(const MLAS u32x4*)(lds + L_QC + rr * QC_RS + (16 * sg + 8 * q2) * 2); const MLAS f32x4* np = (const MLAS f32x4*)(vec + V_NST + 16 * sg + 8 * q2); const f32x4 n0 = np[0], n1 = np[1];
                  s += bflo(qv[0]) * n0[0] + bfhi(qv[0]) * n0[1] + bflo(qv[1]) * n0[2] + bfhi(qv[1]) * n0[3] + bflo(qv[2]) * n1[0] + bfhi(qv[2]) * n1[1] + bflo(qv[3]) * n1[2] + bfhi(qv[3]) * n1[3]; }
              s += dpp_mov<0x111>(0.f, s); s += dpp_mov<0x112>(0.f, s); s += dpp_mov<0x114, 0xf, 0xa>(0.f, s);
              if (sg == 7) vec[V_QN + rr] = s; }
        }
        ML_BAR();
        ML_T(1);
#pragma unroll
        for (int rt = 0; rt < 2; ++rt)
#pragma unroll
            for (int g4 = 0; g4 < 4; ++g4) gz[rt][g4] = *(const u32x2*)(HA + (row0 + t0 + 32 * rt + r32) * DMODEL + h * 256 + 32 * wid + 8 * g4 + 4 * hi);
        {
            bf16x8 vf[4];
            const MLAS unsigned char* vb = lds + L_V + (8 * hi + ((lane >> 2) & 3)) * V_RS + (32 * wid + 16 * ((lane >> 4) & 1) + 4 * (lane & 3)) * 2;
#pragma unroll
            for (int ks = 0; ks < 4; ++ks) vf[ks] = cat8(trrd(vb + 16 * ks * V_RS), trrd(vb + (16 * ks + 4) * V_RS));
            float iv[2], wi[2];
#pragma unroll
            for (int rt = 0; rt < 2; ++rt) { const int row = 32 * rt + r32; const float wI = vec[V_WI + row]; const float den = vec[V_RS2 + row] + vec[V_RS2 + 64 + row] + wI * vec[V_QN + row];
                const float inv = 1.f / fmaxf(fabsf(den), vec[V_EM + row]); iv[rt] = inv; wi[rt] = wI * inv; }
#pragma unroll
            for (int rt = 0; rt < 2; ++rt) {
                bf16x8 pa[4]; u32x4 qf[8];
#pragma unroll
                for (int ks = 0; ks < 4; ++ks) pa[ks] = *(const MLAS bf16x8*)(lds + L_P + (32 * rt + r32) * P_RS + (16 * ks + 8 * hi) * 2);
#pragma unroll
                for (int k8 = 0; k8 < 8; ++k8) { const MLAS unsigned char* qp = lds + L_QC + (32 * rt + r32) * QC_RS + (16 * k8 + 4 * hi) * 2; const u32x2 q0 = *(const MLAS u32x2*)qp, q1 = *(const MLAS u32x2*)(qp + 16); qf[k8] = (u32x4){q0[0], q0[1], q1[0], q1[1]}; }
                ML_SBAR();
                f32x16 an = (f32x16){}, ai = (f32x16){};
#pragma unroll
                for (int ks = 0; ks < 4; ++ks) an = __builtin_amdgcn_mfma_f32_32x32x16_bf16(vf[ks], pa[ks], an, 0, 0, 0);
#pragma unroll
                for (int k8 = 0; k8 < 8; ++k8) {
                    const int kt = k8 >> 1, s8 = 8 * (k8 & 1); if (s8 == 0) asm volatile("" : "+v"(C[kt]));
                    const u32x4 cb = (u32x4){pkbf(C[kt][s8], C[kt][s8 + 1]), pkbf(C[kt][s8 + 2], C[kt][s8 + 3]), pkbf(C[kt][s8 + 4], C[kt][s8 + 5]), pkbf(C[kt][s8 + 6], C[kt][s8 + 7])};
                    ai = __builtin_amdgcn_mfma_f32_32x32x16_bf16(__builtin_bit_cast(bf16x8, cb), __builtin_bit_cast(bf16x8, qf[k8]), ai, 0, 0, 0); }
                ML_SBAR();
                float ss = 0.f;
#pragma unroll
                for (int r = 0; r < 16; ++r) { const float v = an[r] * iv[rt] + ai[r] * wi[rt]; num[rt][r] = v; ss += v * v; }
                { auto rr = __builtin_amdgcn_permlane32_swap(__float_as_uint(ss), __float_as_uint(ss), false, false); ss = __uint_as_float(rr[0]) + __uint_as_float(rr[1]); }
                if (hi == 0) vec[V_SSQ + 64 * wid + 32 * rt + r32] = ss;
            }
            ML_T(2);
            ML_PREFETCH((j + 1 < NCH) ? t0 + 64 : t0);
#pragma unroll
            for (int kt = 0; kt < 4; ++kt) {
                const MLAS unsigned char* kb = lds + L_KW + (8 * hi + ((lane >> 2) & 3)) * KW_RS + (32 * kt + 16 * ((lane >> 4) & 1) + 4 * (lane & 3)) * 2;
                bf16x8 ka[4];
#pragma unroll
                for (int ks = 0; ks < 4; ++ks) ka[ks] = cat8(trrd(kb + 16 * ks * KW_RS), trrd(kb + (16 * ks + 4) * KW_RS));
#pragma unroll
                for (int r = 0; r < 16; ++r) C[kt][r] *= decay;
                ML_SBAR();
#pragma unroll
                for (int ks = 0; ks < 4; ++ks) C[kt] = __builtin_amdgcn_mfma_f32_32x32x16_bf16(ka[ks], vf[ks], C[kt], 0, 0, 0);
            }
            { const int dk = 16 * wid + (lane & 15), sq = lane >> 4; unsigned short kv[16];
#pragma unroll
              for (int i = 0; i < 16; ++i) kv[i] = *(const MLAS unsigned short*)(lds + L_KW + (16 * sq + i) * KW_RS + dk * 2);
              ML_SBAR();
              float s2 = 0.f;
#pragma unroll
              for (int i = 0; i < 16; ++i) s2 += bflo((unsigned)kv[i]);
              s2 += __shfl_xor(s2, 16); s2 += __shfl_xor(s2, 32); if (sq == 0) vec[V_NST + dk] = decay * vec[V_NST + dk] + s2; }
        }
        ML_T(3);
        mprev = mnew;
        ML_BAR();
        ML_T(4);
        ML_T(5);
    }
    { const int lane = lane_now(), r32 = lane & 31, hi = lane >> 5; ML_OUTPUT(SEQ - 64); }
#ifdef PROBE
    if (unit == 0 && wid == 0 && lane_now() == 0) { unsigned long long* tp = tsp; tp[32] = 0; tp[33] = tacc0; tp[34] = tacc1; tp[35] = tacc2; tp[36] = tacc3; tp[37] = tacc4; tp[38] = tacc5; }
#endif
    ML_BAR();
}
#undef ML_PREFETCH
#undef ML_OUTPUT
#undef MLAS
#undef ML_BAR
}
constexpr int NWAVES = 8;
constexpr int BATCH = 8, SEQ = 2048, DM = 1024, M = BATCH * SEQ, PLE = 256, NIN = 10264;
constexpr int C_AQ = 0, C_AK = 512, C_AV = 1024, C_AI = 2048, C_AF = 2052, C_AO = 2056, C_AZ = 3080, C_BQ = 4104, C_BK = 5128, C_BV = 6152, C_BF = 7176, C_BZ = 7192, C_GA = 8216, C_GB = 9240;
constexpr float EPS = 1e-6f;
constexpr size_t MiB = 1u << 20;
constexpr size_t WS_CTL = 0, CTL_ZERO_BYTES = 1 * MiB;
constexpr size_t WS_BT1 = 1 * MiB, WS_BT3 = 17 * MiB, WS_WAT = 21 * MiB, WS_WBT = 23 * MiB, WS_WOT = 25 * MiB, WS_WGT = 27 * MiB, WS_WPT = 29 * MiB;
constexpr size_t WS_LI = 29 * MiB + 512 * 1024, WS_LFA = WS_LI + 256 * 1024, WS_LFB = 30 * MiB;
constexpr size_t WS_S1 = 32 * MiB, WS_S2 = 64 * MiB, WS_S3 = 96 * MiB, WS_S4 = 128 * MiB, WS_S5 = 160 * MiB, WS_S6 = 192 * MiB, WS_S7 = 224 * MiB, WS_END = 256 * MiB;
constexpr size_t DO_SBZ = 0, DO_PB = 32 * MiB, DO_CUMB = 40 * MiB, DO_CB = 41 * MiB;
constexpr int CW_BAR = 4096;
constexpr int LDS_BYTES = 147456, LDS_CTL0 = 139264, MISC_OFF = LDS_CTL0 + 320;

typedef unsigned short bf16;
typedef unsigned v4u __attribute__((ext_vector_type(4)));
#define LDS_WAIT() asm volatile("s_waitcnt lgkmcnt(0)" ::: "memory")
__device__ __forceinline__ unsigned f2bf(float f) { unsigned u = __builtin_bit_cast(unsigned, f); return (u + 0x7fffu + ((u >> 16) & 1u)) >> 16; }
__device__ __forceinline__ unsigned pk2(float lo, float hi) { return f2bf(lo) | (f2bf(hi) << 16); }
__device__ __forceinline__ float bf2f(bf16 v) { return __uint_as_float((unsigned)v << 16); }
__device__ __forceinline__ float wave_sum(float v) {
#pragma unroll
    for (int o = 1; o < 64; o <<= 1) v += __shfl_xor(v, o);
    return v;
}

__device__ __forceinline__ int bt1_src_col(int n) {
    const int tile = n >> 8, r = n & 255;
    if (tile < 4) return C_AQ + 256 * tile + r;
    if (tile < 8) return C_AV + 256 * (tile - 4) + r;
    if (tile < 16) { const int t = tile - 8; return r < 128 ? C_AO + 128 * t + r : C_AZ + 128 * t + (r - 128); }
    if (tile < 20) return C_BQ + 256 * (tile - 16) + r;
    if (tile < 24) return C_BK + 256 * (tile - 20) + r;
    if (tile < 28) return C_BV + 256 * (tile - 24) + r;
    return C_BZ + 256 * (tile - 28) + r;
}
__device__ __forceinline__ int bt3_src_col(int n) { return n < 1024 ? C_GA + n : C_GB + (n - 1024); }

__device__ __forceinline__ void transpose_item(const float* W, int ld, int srccol0, int k0, bf16* WT, int K, int dstrow0, const float* kscale, LAS float* scr, int lane) {
#pragma unroll 8
    for (int i = 0; i < 32; ++i) { const int kk = 2 * i + (lane >> 5); float v = W[(size_t)(k0 + kk) * ld + srccol0 + (lane & 31)]; if (kscale) v *= kscale[k0 + kk]; scr[kk * 33 + (lane & 31)] = v; }
    LDS_WAIT(); asm volatile("" ::: "memory");
    const int c = lane & 7;
#pragma unroll
    for (int j = 0; j < 4; ++j) { const int n = (lane >> 3) + 8 * j; const LAS float* s = scr + (8 * c) * 33 + n;
        v4u o; o.x = pk2(s[0 * 33], s[1 * 33]); o.y = pk2(s[2 * 33], s[3 * 33]); o.z = pk2(s[4 * 33], s[5 * 33]); o.w = pk2(s[6 * 33], s[7 * 33]);
        *(GAS v4u*)(WT + (size_t)(dstrow0 + n) * K + k0 + 8 * c) = o; }
    LDS_WAIT(); asm volatile("" ::: "memory");
}

__device__ __forceinline__ float log_sigmoid_f(float z) { return fminf(z, 0.f) - log1pf(expf(-fabsf(z))); }

struct Args { const float* in[17]; float* out; unsigned char* ws; int ph_lo, ph_hi; };

__device__ __forceinline__ void p0_prologue(const Args& a, LAS unsigned char* lds, int gw, int NGW, int wave, int lane) {
    LAS float* scr = (LAS float*)(lds + wave * 16384);
    unsigned char* ws = a.ws;
    const float* w_in = a.in[3];
    constexpr int I1 = 256 * 16, I3 = 64 * 16, IW = 32 * 16, IP = 32 * 4;
    constexpr int NITEMS = I1 + I3 + 4 * IW + IP;
    for (int it = gw; it < NITEMS; it += NGW) {
        int r = it;
        if (r < I1) { const int nb = r >> 4, kb = r & 15; transpose_item(w_in, NIN, bt1_src_col(32 * nb), 64 * kb, (bf16*)(ws + WS_BT1), 1024, 32 * nb, nullptr, scr, lane); continue; } r -= I1;
        if (r < I3) { const int nb = r >> 4, kb = r & 15; transpose_item(w_in, NIN, bt3_src_col(32 * nb), 64 * kb, (bf16*)(ws + WS_BT3), 1024, 32 * nb, nullptr, scr, lane); continue; } r -= I3;
        if (r < IW) { const int nb = r >> 4, kb = r & 15; transpose_item(a.in[10], 1024, 32 * nb, 64 * kb, (bf16*)(ws + WS_WAT), 1024, 32 * nb, nullptr, scr, lane); continue; } r -= IW;
        if (r < IW) { const int nb = r >> 4, kb = r & 15; transpose_item(a.in[11], 1024, 32 * nb, 64 * kb, (bf16*)(ws + WS_WBT), 1024, 32 * nb, nullptr, scr, lane); continue; } r -= IW;
        if (r < IW) { const int nb = r >> 4, kb = r & 15; transpose_item(a.in[12], 1024, 32 * nb, 64 * kb, (bf16*)(ws + WS_WOT), 1024, 32 * nb, nullptr, scr, lane); continue; } r -= IW;
        if (r < IW) { const int nb = r >> 4, kb = r & 15; transpose_item(a.in[14], 1024, 32 * nb, 64 * kb, (bf16*)(ws + WS_WGT), 1024, 32 * nb, a.in[13], scr, lane); continue; } r -= IW;
        { const int nb = r >> 2, kb = r & 3; transpose_item(a.in[15], 1024, 32 * nb, 64 * kb, (bf16*)(ws + WS_WPT), 256, 32 * nb, nullptr, scr, lane); }
    }
    __syncthreads();
    {
        LAS float* wsm = (LAS float*)lds;
        for (int idx = wave * 64 + lane; idx < 24 * 1024; idx += NWAVES * 64) { const int c = idx >> 10, k = idx & 1023;
            const int col = c < 4 ? C_AI + c : (c < 8 ? C_AF + (c - 4) : C_BF + (c - 8)); wsm[idx] = w_in[(size_t)k * NIN + col]; }
    }
    __syncthreads();
    const float* x = a.in[0]; const float* g = a.in[2];
    f32x4 gv[4];
#pragma unroll
    for (int j = 0; j < 4; ++j) gv[j] = ((const f32x4*)g)[lane + 64 * j];
    float* LI = (float*)(ws + WS_LI); float* LFA = (float*)(ws + WS_LFA); float* LFB = (float*)(ws + WS_LFB);
    for (int m = gw; m < M; m += NGW) {
        const GAS f32x4* xr = (const GAS f32x4*)(x + (size_t)m * DM) + lane; f32x4 v[4]; float s = 0.f;
#pragma unroll
        for (int j = 0; j < 4; ++j) { v[j] = xr[64 * j]; s += (v[j].x * v[j].x + v[j].y * v[j].y) + (v[j].z * v[j].z + v[j].w * v[j].w); }
        const float rstd = 1.f / sqrtf(wave_sum(s) * (1.f / DM) + EPS);
        GAS unsigned long long* o8 = (GAS unsigned long long*)(ws + WS_S1 + (size_t)m * DM * 2) + lane;
#pragma unroll
        for (int j = 0; j < 4; ++j) { v[j] = v[j] * rstd * gv[j]; o8[64 * j] = (unsigned long long)pk2(v[j].x, v[j].y) | ((unsigned long long)pk2(v[j].z, v[j].w) << 32); }
        const LAS f32x4* wsm4 = (const LAS f32x4*)lds;
        float mine = 0.f;
#pragma unroll 1
        for (int c = 0; c < 24; ++c) {
            float d = 0.f;
#pragma unroll
            for (int j = 0; j < 4; ++j) { const f32x4 w = wsm4[c * 256 + lane + 64 * j]; d += (v[j].x * w.x + v[j].y * w.y) + (v[j].z * w.z + v[j].w * w.w); }
            d = wave_sum(d);
            if (lane == c) mine = d;
        }
        if (lane < 4) LI[(size_t)m * 4 + lane] = mine + a.in[6][lane];
        else if (lane < 8) LFA[(size_t)m * 4 + (lane - 4)] = log_sigmoid_f(mine + a.in[7][lane - 4]);
        else if (lane < 24) LFB[(size_t)m * 16 + (lane - 8)] = log_sigmoid_f(mine + a.in[9][lane - 8]);
    }
    const float* p = a.in[1];
    for (int m = gw; m < M; m += NGW) {
        const f32x4 v = ((const GAS f32x4*)(p + (size_t)m * PLE))[lane];
        ((GAS unsigned long long*)((unsigned char*)a.out + DO_PB + (size_t)m * PLE * 2))[lane] = (unsigned long long)pk2(v.x, v.y) | ((unsigned long long)pk2(v.z, v.w) << 32);
    }
}


__device__ __forceinline__ void cum_scan_unit(const float* LFB, float* CUMB, unsigned short* CB, int bh, int lane) {
    const int b = bh >> 4, h = bh & 15; float v[32]; float run = 0.f;
#pragma unroll
    for (int i = 0; i < 32; ++i) { run += LFB[((size_t)b * SEQ + 32 * lane + i) * 16 + h]; v[i] = run; }
    float incl = run;
#pragma unroll
    for (int o = 1; o < 64; o <<= 1) { const float y = __shfl_up(incl, o); if (lane >= o) incl += y; }
    const float excl = incl - run;
#pragma unroll
    for (int i = 0; i < 32; ++i) { const float cum = v[i] + excl; CUMB[(size_t)bh * SEQ + 32 * lane + i] = cum;
        const float c = -1.4426950408889634f * cum; const unsigned h1 = f2bf(c); const float r1 = c - __uint_as_float(h1 << 16); const unsigned h2 = f2bf(r1); const float r2 = r1 - __uint_as_float(h2 << 16); const unsigned h3 = f2bf(r2);
        ((unsigned long long*)CB)[(size_t)bh * SEQ + 32 * lane + i] = (unsigned long long)(h1 | (h2 << 16)) | ((unsigned long long)(h3 | (0x3F80u << 16)) << 32); }
}

__device__ __forceinline__ void mlstm_unit_naive(const bf16* AQK, const bf16* AV, bf16* GATEA_HA, const float* LI, const float* LFA, const float* conv_w, const float* conv_b, const float* hn_g,
                                                 LAS unsigned char* lds, int unit, int tid) {
    const int b = unit >> 2, h = unit & 3, v = tid & 255, half = tid >> 8;
    LAS float* qs = (LAS float*)lds; LAS float* ks = qs + 128; LAS float* nump = ks + 128; LAS float* red = nump + 256; LAS float* red2 = red + 8;
    float C[64];
#pragma unroll
    for (int d = 0; d < 64; ++d) C[d] = 0.f;
    float nreg = 0.f, mst = 0.f;
    const int ch = (v < 128) ? (h * 128 + v) : (512 + h * 128 + (v - 128));
    const float w0 = conv_w[0 * 1024 + ch], w1 = conv_w[1 * 1024 + ch], w2 = conv_w[2 * 1024 + ch], w3 = conv_w[3 * 1024 + ch], cb = conv_b[ch];
    float x0 = 0.f, x1 = 0.f, x2 = 0.f;
    const float hg = hn_g[h * 256 + v];
    for (int t = 0; t < SEQ; ++t) {
        const size_t row = (size_t)b * SEQ + t;
        if (half == 0) {
            const float x3 = bf2f(AQK[row * 1024 + ch]);
            float y = x0 * w0 + x1 * w1 + x2 * w2 + x3 * w3 + cb; x0 = x1; x1 = x2; x2 = x3;
            y = y / (1.f + expf(-y));
            if (v < 128) qs[v] = y; else ks[v - 128] = y * 0.08838834764831845f;
        }
        __syncthreads();
        const float li = LI[row * 4 + h], lf = LFA[row * 4 + h];
        const float mnew = fmaxf(lf + mst, li), fs = expf(lf + mst - mnew), is = expf(li - mnew); mst = mnew;
        const float vt = bf2f(AV[row * 1024 + h * 256 + v]);
        float num = 0.f; const float iv = is * vt;
#pragma unroll
        for (int d = 0; d < 64; ++d) { C[d] = fs * C[d] + iv * ks[64 * half + d]; num += qs[64 * half + d] * C[d]; }
        float dp = 0.f;
        if (tid < 128) { nreg = fs * nreg + is * ks[tid]; dp = nreg * qs[tid]; }
        dp = wave_sum(dp);
        if ((tid & 63) == 0) red[tid >> 6] = dp;
        if (half == 1) nump[v] = num;
        __syncthreads();
        float hval = 0.f;
        if (half == 0) { num += nump[v]; const float den = red[0] + red[1]; hval = num / fmaxf(fabsf(den), expf(-mnew)); }
        const float sq = wave_sum(hval * hval);
        if ((tid & 63) == 0) red2[tid >> 6] = sq;
        __syncthreads();
        if (half == 0) {
            const float ms = (red2[0] + red2[1] + red2[2] + red2[3]) * (1.f / 256.f);
            const size_t o = row * 1024 + h * 256 + v;
            GATEA_HA[o] = (bf16)f2bf(hval * (1.f / sqrtf(ms + EPS)) * hg * bf2f(GATEA_HA[o]));
        }
    }
    __syncthreads();
}

__device__ __forceinline__ void attn_unit_naive(bf16* BQ_HB, const bf16* BK, const bf16* BV, const bf16* SBZ, const float* CUMB, LAS unsigned char* lds, int unit, int tid) {
    const int bh = unit >> 2, qb = unit & 3, b = bh >> 4, h = bh & 15, tq = qb * 512 + tid;
    LAS float* Ks = (LAS float*)lds; LAS float* Vs = Ks + 64 * 65; LAS float* cs = Vs + 64 * 65;
    const size_t rowq = (size_t)b * SEQ + tq;
    float q[64], o[64];
#pragma unroll
    for (int d = 0; d < 64; ++d) { q[d] = bf2f(BQ_HB[rowq * 1024 + h * 64 + d]); o[d] = 0.f; }
    const float L2E = 1.4426950408889634f;
    const float cq = CUMB[(size_t)bh * SEQ + tq] * L2E;
    float mrun = -INFINITY, l = 0.f;
    const int ntile = (qb * 512 + 512) / 64;
    for (int kt = 0; kt < ntile; ++kt) {
        __syncthreads();
        for (int i = tid; i < 64 * 64; i += 512) { const int r = i >> 6, d = i & 63; const size_t rk = ((size_t)b * SEQ + kt * 64 + r) * 1024 + h * 64 + d; Ks[r * 65 + d] = bf2f(BK[rk]); Vs[r * 65 + d] = bf2f(BV[rk]); }
        if (tid < 64) cs[tid] = CUMB[(size_t)bh * SEQ + kt * 64 + tid] * L2E;
        __syncthreads();
        for (int r = 0; r < 64; ++r) {
            const int tk = kt * 64 + r; if (tk > tq) break;
            float sc = 0.f;
#pragma unroll
            for (int d = 0; d < 64; ++d) sc += q[d] * Ks[r * 65 + d];
            sc += cq - cs[r];
            if (sc > mrun) { const float f = exp2f(mrun - sc); l *= f;
#pragma unroll
                for (int d = 0; d < 64; ++d) o[d] *= f;
                mrun = sc; }
            const float pexp = exp2f(sc - mrun); l += pexp;
#pragma unroll
            for (int d = 0; d < 64; ++d) o[d] += pexp * Vs[r * 65 + d];
        }
    }
    const float inv = 1.f / l;
#pragma unroll
    for (int d = 0; d < 64; ++d) { const size_t oo = rowq * 1024 + h * 64 + d; BQ_HB[oo] = (bf16)f2bf(o[d] * inv * bf2f(SBZ[oo])); }
    __syncthreads();
}

__global__ void __launch_bounds__(NWAVES * 64, 2) fwd(Args args) {
    extern __shared__ __attribute__((aligned(16))) unsigned char lds_raw[];
    LAS unsigned char* lds = (LAS unsigned char*)lds_raw;
    const int wave = __builtin_amdgcn_readfirstlane(threadIdx.x >> 6);
    const int G = gridDim.x;
    volatile LAS unsigned* MISC = (volatile LAS unsigned*)(lds + MISC_OFF);
    for (int u = wave * 64 + lane_now(); u < (LDS_BYTES - LDS_CTL0) / 4; u += NWAVES * 64) ((LAS unsigned*)(lds + LDS_CTL0))[u] = 0u;
    __syncthreads();
    unsigned char* ws = args.ws;
    unsigned* ctl = (unsigned*)ws;
    const int lo = args.ph_lo, hi = args.ph_hi;
    XcdBarrier bar; bar.bar = ctl + CW_BAR; bar.x = 0; bar.st = nullptr;
    if (hi - lo > 1) bar = xcd_barrier_post(ctl + CW_BAR, MISC + 8, wave);
#define IN(k) (lo <= (k) && (k) < hi)
#ifdef PROBE
#ifndef PROBE_BLK
#define PROBE_BLK 0
#endif
    unsigned long long* tsw = (unsigned long long*)(ws + 512 * 1024);
#define STAMP(k) do { if ((int)blockIdx.x == PROBE_BLK && wave == 0 && lane_now() == 0) tsw[k] = __builtin_amdgcn_s_memrealtime(); } while (0)
#else
#define STAMP(k) do {} while (0)
#endif
    STAMP(0);
#define BOTH(k) (IN(k) && IN((k) + 1))
    using pg8::bf16_t;
    bf16_t* S1 = (bf16_t*)(ws + WS_S1); bf16_t* S2 = (bf16_t*)(ws + WS_S2); bf16_t* S3 = (bf16_t*)(ws + WS_S3); bf16_t* S4 = (bf16_t*)(ws + WS_S4);
    bf16_t* S5 = (bf16_t*)(ws + WS_S5); bf16_t* S6 = (bf16_t*)(ws + WS_S6);
    float* SSP1 = (float*)(ws + WS_S7); float* SSP2 = (float*)(ws + WS_S7 + MiB);

    if (IN(0)) { p0_prologue(args, lds, (int)blockIdx.x * NWAVES + wave, G * NWAVES, wave, lane_now()); STAMP(1); if (BOTH(0)) xcd_barrier(bar, wave); STAMP(2); }

    if (IN(1)) {
        if (wave == 0 && blockIdx.x < BATCH * 16) cum_scan_unit((const float*)(ws + WS_LFB), (float*)((unsigned char*)args.out + DO_CUMB), (unsigned short*)((unsigned char*)args.out + DO_CB), (int)blockIdx.x, lane_now());
        pg8::Gemm g{S1, (const bf16_t*)(ws + WS_BT1), M, 8192, 1024}; pg8::StaticOrderLim S; S.init(M, 8192, G, (int)blockIdx.x); S.imax = 4;
        pg8::EpiP1 E{S2, (bf16_t*)((unsigned char*)args.out + DO_SBZ)};
        pg8::gemm_phase<pg8::EpiP1, pg8::StaticOrderLim, PG8_ALIGN, PG8_SP2>(lds, g, S, E, wave);
        STAMP(3); if (BOTH(1)) xcd_barrier(bar, wave); STAMP(4);
    }
    if (IN(2)) {
        const int tid = wave * 64 + lane_now();
#ifdef MLSTM_NAIVE
        if (blockIdx.x < BATCH * 4) mlstm_unit_naive((const bf16*)S2, (const bf16*)S3, (bf16*)S4, (const float*)(ws + WS_LI), (const float*)(ws + WS_LFA), args.in[4], args.in[5], args.in[8], lds, (int)blockIdx.x, tid);
#else
        if (blockIdx.x < BATCH * 4) ml::mlstm_unit((const bf16*)S2, (const bf16*)S3, (bf16*)S4, (const float*)(ws + WS_LI), (const float*)(ws + WS_LFA), args.in[4], args.in[5], args.in[8], lds, ((int)blockIdx.x & 7) * 4 + ((int)blockIdx.x >> 3), wave, (unsigned long long*)(ws + 512 * 1024));
#endif
        else {
        { pg8::Gemm g{S1, (const bf16_t*)(ws + WS_BT1), M, 8192, 1024}; pg8::SubsetOrder S{(int)blockIdx.x & 7, ((int)blockIdx.x - BATCH * 4) >> 3, (G - BATCH * 4) >> 3, 16};
          pg8::EpiP1 E{S2, (bf16_t*)((unsigned char*)args.out + DO_SBZ)};
          pg8::gemm_phase<pg8::EpiP1, pg8::SubsetOrder, PG8_ALIGN, PG8_SP2>(lds, g, S, E, wave); }
        sub_barrier(ctl + 2048, (unsigned)(G - BATCH * 4), wave);
        for (int u = (int)blockIdx.x - BATCH * 4; u < BATCH * 16 * 8; u += G - BATCH * 4) {
            const int qb = 7 - (u >> 7), bh = u & 127;
            attn_body::attn_unit<8>(bh >> 4, bh & 15, qb, (const attn_body::bf16*)S5, (const attn_body::bf16*)S6, (const attn_body::bf16*)(ws + WS_S7), (attn_body::bf16*)S5,
                                    (const unsigned short*)((unsigned char*)args.out + DO_CB), (const unsigned short*)((unsigned char*)args.out + DO_SBZ), (char*)lds_raw, wave); }
        }
        STAMP(5); if (BOTH(2)) xcd_barrier(bar, wave); STAMP(6);
    }
    if (IN(3)) {
        { pg8::Gemm g{S1, (const bf16_t*)(ws + WS_BT3), M, 2048, 1024}; pg8::StaticOrder S; S.init(M, 2048, G, (int)blockIdx.x);
          pg8::EpiBf16Split<1> E{S2, S3};
          pg8::gemm_phase<pg8::EpiBf16Split<1>, pg8::StaticOrder, PG8_ALIGN, PG8_SP2>(lds, g, S, E, wave); }
        { int kpp = 256; asm volatile("" : "+s"(kpp));
          pg8::Gemm g{(const bf16_t*)((unsigned char*)args.out + DO_PB), (const bf16_t*)(ws + WS_WPT), M, 1024, kpp}; pg8::StaticOrder S; S.init(M, 1024, G, (int)blockIdx.x);
          pg8::EpiBf16Split<0> E{S6, S6};
          pg8::gemm_phase<pg8::EpiBf16Split<0>, pg8::StaticOrder, PG8_ALIGN, PG8_SP2>(lds, g, S, E, wave); }
        STAMP(7); if (BOTH(3)) xcd_barrier(bar, wave); STAMP(8);
    }
    if (IN(4)) {
        { pg8::Gemm g{S4, (const bf16_t*)(ws + WS_WAT), M, 1024, 1024}; pg8::StaticOrder S; S.init(M, 1024, G, (int)blockIdx.x);
          pg8::EpiGate<0> E{S2, nullptr};
          pg8::gemm_phase<pg8::EpiGate<0>, pg8::StaticOrder, false, PG8_SP2>(lds, g, S, E, wave); }
        { pg8::Gemm g{S5, (const bf16_t*)(ws + WS_WBT), M, 1024, 1024}; pg8::StaticOrder S; S.init(M, 1024, G, (int)blockIdx.x);
          pg8::EpiGate<1> E{S2, S3};
          pg8::gemm_phase<pg8::EpiGate<1>, pg8::StaticOrder, false, PG8_SP2>(lds, g, S, E, wave); }
        STAMP(9); if (BOTH(4)) xcd_barrier(bar, wave); STAMP(10);
    }
    if (IN(5)) {
        pg8::Gemm g{S2, (const bf16_t*)(ws + WS_WOT), M, 1024, 1024}; pg8::StaticOrder S; S.init(M, 1024, G, (int)blockIdx.x);
        pg8::EpiRes E{args.in[0], args.out, S1, SSP1};
        pg8::gemm_phase<pg8::EpiRes, pg8::StaticOrder, false, PG8_SP2>(lds, g, S, E, wave);
        STAMP(11); if (BOTH(5)) xcd_barrier(bar, wave); STAMP(12);
    }
    if (IN(6)) {
        pg8::Gemm g{S1, (const bf16_t*)(ws + WS_WGT), M, 1024, 1024}; pg8::StaticOrder S; S.init(M, 1024, G, (int)blockIdx.x);
        pg8::EpiPle E{args.out, S6, SSP1, SSP2, EPS};
        pg8::gemm_phase<pg8::EpiPle, pg8::StaticOrder, false, PG8_SP2>(lds, g, S, E, wave);
        STAMP(13); if (BOTH(6)) xcd_barrier(bar, wave); STAMP(14);
    }
    if (IN(7)) {
        const int lane = lane_now(); const float* gf = args.in[16];
        for (int m = (int)blockIdx.x * NWAVES + wave; m < M; m += G * NWAVES) {
            const f32x4* sp = (const f32x4*)(SSP2 + (size_t)m * 16); const f32x4 s0 = sp[0], s1 = sp[1], s2 = sp[2], s3 = sp[3];
            const float tot = ((s0[0] + s0[1]) + (s0[2] + s0[3])) + ((s1[0] + s1[1]) + (s1[2] + s1[3])) + ((s2[0] + s2[1]) + (s2[2] + s2[3])) + ((s3[0] + s3[1]) + (s3[2] + s3[3]));
            const float rstd = 1.f / sqrtf(tot * (1.f / DM) + EPS);
            f32x4* xr = (f32x4*)(args.out + (size_t)m * DM) + lane;
#pragma unroll
            for (int j = 0; j < 4; ++j) { const f32x4 gv = ((const f32x4*)gf)[lane + 64 * j]; xr[64 * j] = xr[64 * j] * rstd * gv; }
        }
    }
#ifdef PROBE
    STAMP(15); xcd_barrier(bar, wave);
    { const unsigned long long t0 = __hip_atomic_load(tsw + PROBE_A, __ATOMIC_RELAXED, __HIP_MEMORY_SCOPE_AGENT);
      const unsigned long long t1 = __hip_atomic_load(tsw + PROBE_B, __ATOMIC_RELAXED, __HIP_MEMORY_SCOPE_AGENT), t2 = __hip_atomic_load(tsw + PROBE_B2, __ATOMIC_RELAXED, __HIP_MEMORY_SCOPE_AGENT);
      const float u1 = 1000.f * exp2f(floorf(log2f(fmaxf((float)(t1 - t0) * 0.01f, 0.01f)) * PROBE_GRID + PROBE_OFS) / PROBE_GRID), u2 = 1000.f * exp2f(floorf(log2f(fmaxf((float)(t2 - t0) * 0.01f, 0.01f)) * PROBE_GRID + PROBE_OFS) / PROBE_GRID);
      const int lane = lane_now();
      for (int m = (int)blockIdx.x * NWAVES + wave; m < M; m += G * NWAVES) { f32x4* xr = (f32x4*)(args.out + (size_t)m * DM) + lane; const float us = (m < M / 2) ? u1 : u2;
#pragma unroll
          for (int j = 0; j < 4; ++j) xr[64 * j] = (f32x4){us, us, us, us}; } }
#endif
#undef IN
#undef BOTH
}


__global__ void __launch_bounds__(256) small_gates_naive(const bf16* XN, const float* w_in, const float* bias_i, const float* bias_fa, const float* bias_fb, float* LI, float* LFA, float* LFB) {
    const int lane = threadIdx.x & 63, row = blockIdx.x * 4 + (threadIdx.x >> 6);
    float xv[16];
#pragma unroll
    for (int i = 0; i < 16; ++i) xv[i] = bf2f(XN[(size_t)row * DM + lane + 64 * i]);
    for (int c = 0; c < 24; ++c) {
        const int col = c < 4 ? C_AI + c : (c < 8 ? C_AF + (c - 4) : C_BF + (c - 8));
        float s = 0.f;
#pragma unroll
        for (int i = 0; i < 16; ++i) s += xv[i] * w_in[(size_t)(lane + 64 * i) * NIN + col];
        s = wave_sum(s);
        if (lane == 0) {
            if (c < 4) LI[(size_t)row * 4 + c] = s + bias_i[c];
            else if (c < 8) LFA[(size_t)row * 4 + (c - 4)] = log_sigmoid_f(s + bias_fa[c - 4]);
            else LFB[(size_t)row * 16 + (c - 8)] = log_sigmoid_f(s + bias_fb[c - 8]);
        }
    }
}

__global__ void __launch_bounds__(256) mlstm_naive(const bf16* AQK, const bf16* AV, bf16* GATEA_HA, const float* LI, const float* LFA, const float* conv_w, const float* conv_b, const float* hn_g) {
    const int b = blockIdx.x >> 2, h = blockIdx.x & 3, v = threadIdx.x;
    __shared__ float qs[128], ks[128], red[8], red2[8];
    float C[128];
#pragma unroll
    for (int d = 0; d < 128; ++d) C[d] = 0.f;
    float nreg = 0.f, mst = 0.f;
    const int ch = (v < 128) ? (h * 128 + v) : (512 + h * 128 + (v - 128));
    const float w0 = conv_w[0 * 1024 + ch], w1 = conv_w[1 * 1024 + ch], w2 = conv_w[2 * 1024 + ch], w3 = conv_w[3 * 1024 + ch], cb = conv_b[ch];
    float x0 = 0.f, x1 = 0.f, x2 = 0.f;
    const float hg = hn_g[h * 256 + v];
    for (int t = 0; t < SEQ; ++t) {
        const size_t row = (size_t)b * SEQ + t;
        const float x3 = bf2f(AQK[row * 1024 + ch]);
        float y = x0 * w0 + x1 * w1 + x2 * w2 + x3 * w3 + cb; x0 = x1; x1 = x2; x2 = x3;
        y = y / (1.f + expf(-y));
        if (v < 128) qs[v] = y; else ks[v - 128] = y * 0.08838834764831845f;
        __syncthreads();
        const float li = LI[row * 4 + h], lf = LFA[row * 4 + h];
        const float mnew = fmaxf(lf + mst, li), fs = expf(lf + mst - mnew), is = expf(li - mnew); mst = mnew;
        const float vt = bf2f(AV[row * 1024 + h * 256 + v]);
        float num = 0.f; const float iv = is * vt;
#pragma unroll
        for (int d = 0; d < 128; ++d) { C[d] = fs * C[d] + iv * ks[d]; num += qs[d] * C[d]; }
        float dp = 0.f;
        if (v < 128) { nreg = fs * nreg + is * ks[v]; dp = nreg * qs[v]; }
        dp = wave_sum(dp);
        if ((v & 63) == 0) red[v >> 6] = dp;
        __syncthreads();
        const float den = red[0] + red[1] + red[2] + red[3];
        const float hval = num / fmaxf(fabsf(den), expf(-mnew));
        float sq = wave_sum(hval * hval);
        if ((v & 63) == 0) red2[v >> 6] = sq;
        __syncthreads();
        const float ms = (red2[0] + red2[1] + red2[2] + red2[3]) * (1.f / 256.f);
        const size_t o = row * 1024 + h * 256 + v;
        const float outv = hval * (1.f / sqrtf(ms + EPS)) * hg * bf2f(GATEA_HA[o]);
        GATEA_HA[o] = (bf16)f2bf(outv);
    }
}

__global__ void cum_naive(const float* LFB, float* CUMB) {
    const int i = blockIdx.x * blockDim.x + threadIdx.x; if (i >= BATCH * 16) return;
    const int b = i >> 4, h = i & 15; float s = 0.f;
    for (int t = 0; t < SEQ; ++t) { s += LFB[((size_t)b * SEQ + t) * 16 + h]; CUMB[(size_t)i * SEQ + t] = s; }
}

__global__ void __launch_bounds__(256) attn_naive(bf16* BQ_HB, const bf16* BK, const bf16* BV, const bf16* SBZ, const float* CUMB) {
    const int bh = blockIdx.x >> 3, qb = blockIdx.x & 7, b = bh >> 4, h = bh & 15, tq = qb * 256 + threadIdx.x;
    __shared__ float Ks[64][65], Vs[64][65], cs[64];
    const size_t rowq = (size_t)b * SEQ + tq;
    float q[64], o[64];
#pragma unroll
    for (int d = 0; d < 64; ++d) { q[d] = bf2f(BQ_HB[rowq * 1024 + h * 64 + d]); o[d] = 0.f; }
    const float L2E = 1.4426950408889634f;
    const float cq = CUMB[(size_t)bh * SEQ + tq] * L2E;
    float mrun = -INFINITY, l = 0.f;
    const int ntile = (qb * 256 + 256) / 64;
    for (int kt = 0; kt < ntile; ++kt) {
        __syncthreads();
        for (int i = threadIdx.x; i < 64 * 64; i += 256) { const int r = i >> 6, d = i & 63; const size_t rk = ((size_t)b * SEQ + kt * 64 + r) * 1024 + h * 64 + d; Ks[r][d] = bf2f(BK[rk]); Vs[r][d] = bf2f(BV[rk]); }
        if (threadIdx.x < 64) cs[threadIdx.x] = CUMB[(size_t)bh * SEQ + kt * 64 + threadIdx.x] * L2E;
        __syncthreads();
        for (int r = 0; r < 64; ++r) {
            const int tk = kt * 64 + r; if (tk > tq) break;
            float s = 0.f;
#pragma unroll
            for (int d = 0; d < 64; ++d) s += q[d] * Ks[r][d];
            s += cq - cs[r];
            if (s > mrun) { const float f = exp2f(mrun - s); l *= f;
#pragma unroll
                for (int d = 0; d < 64; ++d) o[d] *= f;
                mrun = s; }
            const float pexp = exp2f(s - mrun); l += pexp;
#pragma unroll
            for (int d = 0; d < 64; ++d) o[d] += pexp * Vs[r][d];
        }
    }
    const float inv = 1.f / l;
#pragma unroll
    for (int d = 0; d < 64; ++d) { const size_t oo = rowq * 1024 + h * 64 + d; BQ_HB[oo] = (bf16)f2bf(o[d] * inv * bf2f(SBZ[oo])); }
}

__global__ void __launch_bounds__(256) final_naive(float* X, const float* SSP2, const float* g) {
    const int lane = threadIdx.x & 63, row = blockIdx.x * 4 + (threadIdx.x >> 6);
    float tot = 0.f;
    for (int i = 0; i < 16; ++i) tot += SSP2[(size_t)row * 16 + i];
    const float rstd = 1.f / sqrtf(tot * (1.f / DM) + EPS);
    f32x4* xr = (f32x4*)(X + (size_t)row * DM) + lane;
#pragma unroll
    for (int j = 0; j < 4; ++j) { const f32x4 gv = ((const f32x4*)g)[lane + 64 * j]; xr[64 * j] = xr[64 * j] * rstd * gv; }
}


#ifdef DBG
__device__ __forceinline__ unsigned hash_u(unsigned x) { x ^= x >> 16; x *= 0x7feb352du; x ^= x >> 15; x *= 0x846ca68bu; x ^= x >> 16; return x; }
__device__ __forceinline__ float rbf(float f) { return __uint_as_float(f2bf(f) << 16); }
__device__ __forceinline__ float dot_bf(const bf16* a, const float* W, int ld, int col, int K, const float* ks) {
    float s = 0.f; for (int k = 0; k < K; ++k) { float w = W[(size_t)k * ld + col]; if (ks) w *= ks[k]; s += bf2f(a[k]) * rbf(w); } return s; }
__device__ __forceinline__ void report(float* slot, float stored, float expect) { const float d = fabsf(stored - expect) / (fabsf(expect) + 0.05f); atomicMax((unsigned*)slot, __float_as_uint(d)); }
__device__ __forceinline__ float sgm(float x) { return 1.f / (1.f + expf(-x)); }
__global__ void chk_p1(const bf16* XN, const float* w_in, const unsigned char* ws, const unsigned char* dob, float* slot) {
    const unsigned s = blockIdx.x * blockDim.x + threadIdx.x; const unsigned hsh = hash_u(s * 2654435761u + 12345u);
    const int arr = s % 7, row = hsh % M, col = (hsh >> 14) % 1024; const bf16* a = XN + (size_t)row * DM;
    float e; const bf16* st;
    switch (arr) {
    case 0: e = dot_bf(a, w_in, NIN, C_AQ + col, 1024, nullptr); st = (const bf16*)(ws + WS_S2); break;
    case 1: e = dot_bf(a, w_in, NIN, C_AV + col, 1024, nullptr); st = (const bf16*)(ws + WS_S3); break;
    case 2: { const float o = dot_bf(a, w_in, NIN, C_AO + col, 1024, nullptr), z = dot_bf(a, w_in, NIN, C_AZ + col, 1024, nullptr); e = sgm(o) * z * sgm(z); st = (const bf16*)(ws + WS_S4); } break;
    case 3: e = dot_bf(a, w_in, NIN, C_BQ + col, 1024, nullptr) * pg8::QSCALE; st = (const bf16*)(ws + WS_S5); break;
    case 4: e = dot_bf(a, w_in, NIN, C_BK + col, 1024, nullptr); st = (const bf16*)(ws + WS_S6); break;
    case 5: e = dot_bf(a, w_in, NIN, C_BV + col, 1024, nullptr); st = (const bf16*)(ws + WS_S7); break;
    default: { const float z = dot_bf(a, w_in, NIN, C_BZ + col, 1024, nullptr); e = z * sgm(z); st = (const bf16*)(dob + DO_SBZ); } break;
    }
    report(slot, bf2f(st[(size_t)row * 1024 + col]), e);
}
__global__ void chk_p3(const bf16* XN, const float* w_in, const bf16* Pb, const float* w_pp, const unsigned char* ws, float* slot) {
    const unsigned s = blockIdx.x * blockDim.x + threadIdx.x; const unsigned hsh = hash_u(s * 2654435761u + 777u);
    const int arr = s % 3, row = hsh % M, col = (hsh >> 14) % 1024; float e; const bf16* st;
    if (arr == 0) { e = sgm(dot_bf(XN + (size_t)row * DM, w_in, NIN, C_GA + col, 1024, nullptr)); st = (const bf16*)(ws + WS_S2); }
    else if (arr == 1) { e = sgm(dot_bf(XN + (size_t)row * DM, w_in, NIN, C_GB + col, 1024, nullptr)); st = (const bf16*)(ws + WS_S3); }
    else { e = dot_bf(Pb + (size_t)row * PLE, w_pp, 1024, col, 256, nullptr); st = (const bf16*)(ws + WS_S6); }
    report(slot + (arr == 0 ? 0 : (arr == 1 ? 5 : 6)), bf2f(st[(size_t)row * 1024 + col]), e);
}
__global__ void chk_p4(const unsigned char* ws, const float* w_in, const float* w_a, const float* w_b, float* slot) {
    const unsigned s = blockIdx.x * blockDim.x + threadIdx.x; const unsigned hsh = hash_u(s * 2654435761u + 999u);
    const int row = hsh % M, col = (hsh >> 14) % 1024; const bf16* XN = (const bf16*)(ws + WS_S1) + (size_t)row * DM;
    const float ga = rbf(sgm(dot_bf(XN, w_in, NIN, C_GA + col, 1024, nullptr))), gb = rbf(sgm(dot_bf(XN, w_in, NIN, C_GB + col, 1024, nullptr)));
    const float ya = dot_bf((const bf16*)(ws + WS_S4) + (size_t)row * DM, w_a, 1024, col, 1024, nullptr), yb = dot_bf((const bf16*)(ws + WS_S5) + (size_t)row * DM, w_b, 1024, col, 1024, nullptr);
    report(slot, bf2f(((const bf16*)(ws + WS_S2))[(size_t)row * 1024 + col]), rbf(ga * ya) + gb * yb);
}
__global__ void chk_p5(const unsigned char* ws, const float* x, const float* w_out, const float* X1, float* slot) {
    const unsigned s = blockIdx.x * blockDim.x + threadIdx.x; const unsigned hsh = hash_u(s * 2654435761u + 4242u);
    const int row = hsh % M, col = (hsh >> 14) % 1024;
    const float e = x[(size_t)row * DM + col] + dot_bf((const bf16*)(ws + WS_S2) + (size_t)row * DM, w_out, 1024, col, 1024, nullptr);
    report(slot, X1[(size_t)row * DM + col], e);
    report(slot, bf2f(((const bf16*)(ws + WS_S1))[(size_t)row * DM + col]), e);
    if ((s & 63) == 0) { float ss = 0.f, sp = 0.f; for (int k = 0; k < DM; ++k) { const float v = X1[(size_t)row * DM + k]; ss += v * v; } for (int k = 0; k < 16; ++k) sp += ((const float*)(ws + WS_S7))[(size_t)row * 16 + k];
        report(slot, sp, ss); }
}
__global__ void chk_p6(const unsigned char* ws, const float* w_pg, const float* gple, const float* X2, float* slot) {
    const unsigned s = blockIdx.x * blockDim.x + threadIdx.x; const unsigned hsh = hash_u(s * 2654435761u + 31337u);
    const int row = hsh % M, col = (hsh >> 14) % 1024; const bf16* xb = (const bf16*)(ws + WS_S1) + (size_t)row * DM;
    float ss = 0.f; for (int k = 0; k < DM; ++k) { const float v = bf2f(xb[k]); ss += v * v; }
    const float rstd = 1.f / sqrtf(ss / DM + EPS);
    const float z = rstd * dot_bf(xb, w_pg, 1024, col, 1024, gple);
    const float e = bf2f(xb[col]) + sgm(z) * bf2f(((const bf16*)(ws + WS_S6))[(size_t)row * DM + col]);
    report(slot, X2[(size_t)row * DM + col], e);
    if ((s & 63) == 0) { float s2 = 0.f, sp = 0.f; for (int k = 0; k < DM; ++k) { const float v = X2[(size_t)row * DM + k]; s2 += v * v; } for (int k = 0; k < 16; ++k) sp += ((const float*)(ws + WS_S7 + MiB))[(size_t)row * 16 + k];
        report(slot, sp, s2); }
}

__global__ void chk_bt3(const bf16* Bt3, const float* w_in, const bf16* GA, const bf16* XN, float* slot) {
    const unsigned s = blockIdx.x * blockDim.x + threadIdx.x; const unsigned hsh = hash_u(s * 2654435761u + 555u);
    unsigned* cnt = (unsigned*)slot;
    { const int row = (hsh % M) | 128, col = (hsh >> 14) % 1024; const float e = sgm(dot_bf(XN + (size_t)row * DM, w_in, NIN, C_GA + col, 1024, nullptr)); const float st = bf2f(GA[(size_t)row * 1024 + col]);
      const float d = fabsf(st - e) / (fabsf(e) + 0.05f);
      atomicAdd(cnt + 0, 1u);
      if (d > 0.03f) { atomicAdd(cnt + 1, 1u); const float e2 = dot_bf(XN + (size_t)row * DM, w_in, NIN, C_AQ + col, 1024, nullptr); if (fabsf(st - e2) / (fabsf(e2) + 0.05f) < 0.03f) atomicAdd(cnt + 2, 1u); } }
}
__global__ void dbg_fill(float* out, const float* slots) {
    float code = 0.f;
    { const int order[6] = {1, 3, 8, 9, 4, 5}; int mask = 0; for (int k = 0; k < 6; ++k) if (slots[order[k]] > 0.03f) mask |= 1 << k; if (slots[6] > 0.03f) mask |= 64; code = 100.f * mask; }
#if DBG >= 10
    code = slots[DBG - 10] * 1e4f;
#endif
    const size_t i = (size_t)blockIdx.x * blockDim.x + threadIdx.x; out[i] = code;
}
#endif
extern "C" void kernel_launch(void* const* d_in, const int* in_sizes, int n_in, void* d_out, int out_size, void* d_ws, size_t ws_size, hipStream_t stream) {
    static int grid = 0;
    if (grid == 0) {
        int dev = 0, cus = 0;
        if (n_in != 17 || out_size != M * DM || ws_size < WS_END) { fprintf(stderr, "kernel_launch: unexpected shapes (n_in %d out %d ws %zu)\n", n_in, out_size, ws_size); grid = -1; return; }
        if (hipGetDevice(&dev) != hipSuccess || hipDeviceGetAttribute(&cus, hipDeviceAttributeMultiprocessorCount, dev) != hipSuccess) { grid = -1; return; }
        if (hipFuncSetAttribute((const void*)fwd, hipFuncAttributeMaxDynamicSharedMemorySize, LDS_BYTES) != hipSuccess) { grid = -1; return; }
        grid = cus;
    }
    if (grid < 0) return;
    (void)hipMemsetAsync((char*)d_ws + WS_CTL, 0, CTL_ZERO_BYTES, stream);
    Args a{};
    for (int i = 0; i < 17; ++i) a.in[i] = (const float*)d_in[i];
    a.out = (float*)d_out; a.ws = (unsigned char*)d_ws;
    unsigned char* ws = (unsigned char*)d_ws; unsigned char* dob = (unsigned char*)d_out;
    a.ph_lo = 0; a.ph_hi = 8;
    hipLaunchKernelGGL(fwd, dim3(grid), dim3(NWAVES * 64), LDS_BYTES, stream, a);
}
```
